# Optimizing an MI355X kernel written in HIP

```python
import math
import jax
import jax.numpy as jnp
from jax import lax
import numpy as np

D_MODEL = 2048
BATCH = 8
SEQ = 2048
DEPTH = 2

FOX_HEADS = 8
FOX_HEAD_DIM = 128
FOX_WIDTH = FOX_HEADS * FOX_HEAD_DIM
SSM_WIDTH = D_MODEL - FOX_WIDTH
SSM_GROUP = 16
SSM_GROUPS = SSM_WIDTH // SSM_GROUP
SSM_STATE = 64
EVEN_IN = 3 * FOX_WIDTH + FOX_HEADS + SSM_WIDTH
FORGET_BIAS_INIT = 2.0
DT_MIN = 1e-3
DT_MAX = 1e-1
SWA_HEADS = 32
SWA_KV_HEADS = 4
SWA_HEAD_DIM = 64
SWA_GROUPS = SWA_HEADS // SWA_KV_HEADS
SWA_WINDOW = 128
ODD_IN = (SWA_HEADS + 2 * SWA_KV_HEADS) * SWA_HEAD_DIM
ROPE_DIM = SWA_HEAD_DIM // 4
ROPE_THETA = 500000.0
Q_BLOCK = 128
D_FF = 5504
CONV_WIDTH = 3
LN_EPS = 1e-5
DEEPNORM_ALPHA = (2.0 * DEPTH) ** 0.25
DEEPNORM_BETA = (8.0 * DEPTH) ** -0.25
N_EVEN = (DEPTH + 1) // 2
N_ODD = DEPTH // 2

kernel_name = 'hybrid_fox_s5_swa_deepnorm'


def _layer_norm(x, g, b):
    x32 = x.astype(jnp.float32)
    mu = jnp.mean(x32, axis=-1, keepdims=True)
    var = jnp.mean(jnp.square(x32 - mu), axis=-1, keepdims=True)
    y = (x32 - mu) * lax.rsqrt(var + LN_EPS)
    return (y * g.astype(jnp.float32) + b.astype(jnp.float32)).astype(x.dtype)


def _forgetting_attention(q, k, v, f_logit):
    s_len = q.shape[1]
    dh = q.shape[-1]
    scale = 1.0 / math.sqrt(dh)
    log_f = jax.nn.log_sigmoid(f_logit.astype(jnp.float32))
    c = jnp.cumsum(log_f, axis=1).transpose(0, 2, 1)
    outs = []
    for start in range(0, s_len, Q_BLOCK):
        end = start + Q_BLOCK
        s = jnp.einsum('bqhd,bkhd->bhqk', q[:, start:end], k[:, :end]).astype(jnp.float32) * scale
        s = s + c[:, :, start:end, None] - c[:, :, None, :end]
        causal = jnp.arange(start, end)[:, None] >= jnp.arange(end)[None, :]
        s = jnp.where(causal, s, -jnp.inf)
        p = jax.nn.softmax(s, axis=-1).astype(v.dtype)
        outs.append(jnp.einsum('bhqk,bkhd->bqhd', p, v[:, :end]))
    return jnp.concatenate(outs, axis=1)


def _s5_scan(u, lam_re, lam_im, log_step, b_re, b_im, c_re, c_im, d_skip):
    u32 = u.astype(jnp.float32)
    lr = lam_re.astype(jnp.float32)
    li = lam_im.astype(jnp.float32)
    dt = jnp.exp(log_step.astype(jnp.float32))[:, None]
    mag = jnp.exp(lr * dt)
    a_re = mag * jnp.cos(li * dt)
    a_im = mag * jnp.sin(li * dt)
    den = lr * lr + li * li
    xr = a_re - 1.0
    xi = a_im
    g_re = (xr * lr + xi * li) / den
    g_im = (xi * lr - xr * li) / den
    br = b_re.astype(jnp.float32)
    bi = b_im.astype(jnp.float32)
    bb_re = g_re[..., None] * br - g_im[..., None] * bi
    bb_im = g_re[..., None] * bi + g_im[..., None] * br
    bu_re = jnp.einsum('gpc,bsgc->bsgp', bb_re, u32)
    bu_im = jnp.einsum('gpc,bsgc->bsgp', bb_im, u32)

    def combine(e1, e2):
        a1r, a1i, b1r, b1i = e1
        a2r, a2i, b2r, b2i = e2
        return (a2r * a1r - a2i * a1i,
                a2r * a1i + a2i * a1r,
                a2r * b1r - a2i * b1i + b2r,
                a2r * b1i + a2i * b1r + b2i)

    s_len = u.shape[1]
    a_re_t = jnp.broadcast_to(a_re[None, None], (1, s_len) + a_re.shape)
    a_im_t = jnp.broadcast_to(a_im[None, None], (1, s_len) + a_im.shape)
    _, _, h_re, h_im = lax.associative_scan(combine, (a_re_t, a_im_t, bu_re, bu_im), axis=1)
    y = (jnp.einsum('gcp,bsgp->bsgc', c_re.astype(jnp.float32), h_re)
         - jnp.einsum('gcp,bsgp->bsgc', c_im.astype(jnp.float32), h_im)
         + d_skip.astype(jnp.float32) * u32)
    return y.astype(u.dtype)


def _partial_rope(x, positions):
    half = ROPE_DIM // 2
    inv_freq = ROPE_THETA ** (-jnp.arange(half, dtype=jnp.float32) / half)
    ang = positions.astype(jnp.float32)[..., None] * inv_freq
    cos = jnp.cos(ang)[:, :, None, :]
    sin = jnp.sin(ang)[:, :, None, :]
    xr = x[..., :ROPE_DIM].astype(jnp.float32)
    x1 = xr[..., :half]
    x2 = xr[..., half:]
    rot = jnp.concatenate([x1 * cos - x2 * sin, x2 * cos + x1 * sin], axis=-1).astype(x.dtype)
    return jnp.concatenate([rot, x[..., ROPE_DIM:]], axis=-1)


def _sliding_window_attention(q, k, v, sinks):
    bsz, s_len, _, dh = q.shape
    nb = s_len // Q_BLOCK
    scale = 1.0 / math.sqrt(dh)
    qb = q.reshape(bsz, nb, Q_BLOCK, SWA_KV_HEADS, SWA_GROUPS, dh)
    kb = k.reshape(bsz, nb, Q_BLOCK, SWA_KV_HEADS, dh)
    vb = v.reshape(bsz, nb, Q_BLOCK, SWA_KV_HEADS, dh)
    pad = ((0, 0), (1, 0), (0, 0), (0, 0), (0, 0))
    kk = jnp.concatenate([jnp.pad(kb, pad)[:, :-1], kb], axis=2)
    vv = jnp.concatenate([jnp.pad(vb, pad)[:, :-1], vb], axis=2)
    s = jnp.einsum('bnqhgd,bnkhd->bnhgqk', qb, kk).astype(jnp.float32) * scale
    qi = jnp.arange(Q_BLOCK)[:, None]
    kj = jnp.arange(2 * Q_BLOCK)[None, :]
    rel = Q_BLOCK + qi - kj
    band = (rel >= 0) & (rel < SWA_WINDOW)
    exists = (jnp.arange(nb)[:, None, None] > 0) | (kj[None] >= Q_BLOCK)
    valid = band[None] & exists
    s = jnp.where(valid[None, :, None, None], s, -jnp.inf)
    sink = jnp.broadcast_to(
        sinks.astype(jnp.float32).reshape(SWA_KV_HEADS, SWA_GROUPS)[None, None, :, :, None, None],
        s.shape[:-1] + (1,))
    p = jax.nn.softmax(jnp.concatenate([s, sink], axis=-1), axis=-1)[..., :-1]
    o = jnp.einsum('bnhgqk,bnkhd->bnqhgd', p.astype(v.dtype), vv)
    return o.reshape(bsz, s_len, SWA_HEADS * dh)


def _even_mixer(x, w_in, b_f, lam_re, lam_im, log_step, b_re, b_im, c_re, c_im, d_skip, w_glu, w_out):
    bsz, s_len, _ = x.shape
    proj = jnp.einsum('bsd,de->bse', x, w_in)
    q, k, v, f_logit, u = jnp.split(
        proj, [FOX_WIDTH, 2 * FOX_WIDTH, 3 * FOX_WIDTH, 3 * FOX_WIDTH + FOX_HEADS], axis=-1)
    hs = (bsz, s_len, FOX_HEADS, FOX_HEAD_DIM)
    fox = _forgetting_attention(q.reshape(hs), k.reshape(hs), v.reshape(hs), f_logit + b_f)
    fox = fox.reshape(bsz, s_len, FOX_WIDTH)
    y = _s5_scan(u.reshape(bsz, s_len, SSM_GROUPS, SSM_GROUP),
                 lam_re, lam_im, log_step, b_re, b_im, c_re, c_im, d_skip)
    z = jnp.einsum('bsc,ce->bse', jax.nn.gelu(y.reshape(bsz, s_len, SSM_WIDTH)), w_glu)
    ssm = z[..., :SSM_WIDTH] * jax.nn.sigmoid(z[..., SSM_WIDTH:])
    return jnp.einsum('bsc,cd->bsd', jnp.concatenate([fox, ssm], axis=-1), w_out)


def _odd_mixer(x, positions, w_in, sinks, w_out):
    bsz, s_len, _ = x.shape
    proj = jnp.einsum('bsd,de->bse', x, w_in)
    qw = SWA_HEADS * SWA_HEAD_DIM
    kw = SWA_KV_HEADS * SWA_HEAD_DIM
    q, k, v = jnp.split(proj, [qw, qw + kw], axis=-1)
    q = _partial_rope(q.reshape(bsz, s_len, SWA_HEADS, SWA_HEAD_DIM), positions)
    k = _partial_rope(k.reshape(bsz, s_len, SWA_KV_HEADS, SWA_HEAD_DIM), positions)
    v = v.reshape(bsz, s_len, SWA_KV_HEADS, SWA_HEAD_DIM)
    o = _sliding_window_attention(q, k, v, sinks)
    return jnp.einsum('bsc,cd->bsd', o, w_out)


def _conv_ffn(x, w_up, conv_w, conv_b, w_down):
    s_len = x.shape[1]
    h = jnp.einsum('bsd,df->bsf', x, w_up)
    hp = jnp.pad(h, ((0, 0), (CONV_WIDTH - 1, 0), (0, 0)))
    h = conv_b + sum(conv_w[t] * hp[:, t:t + s_len] for t in range(CONV_WIDTH))
    gate = h[..., :D_FF]
    val = h[..., D_FF:]
    return jnp.einsum('bsf,fd->bsd', jax.nn.silu(gate) * val, w_down)


def setup_inputs(seed: int = 0) -> dict:
    key = jax.random.key(seed)
    ks = jax.random.split(key, 26)
    f32 = jnp.float32

    def nrm(k, shape, scale):
        return jax.random.normal(k, shape, f32) * scale

    x = nrm(ks[0], (BATCH, SEQ, D_MODEL), 1.0)
    offs = jax.random.randint(ks[1], (BATCH, 1), 0, 1024, dtype=jnp.int32)
    positions = (offs + jnp.arange(SEQ, dtype=jnp.int32)[None, :]).astype(jnp.int32)

    ev_w_in = nrm(ks[2], (N_EVEN, D_MODEL, EVEN_IN), D_MODEL ** -0.5)
    ev_w_in = ev_w_in.at[:, :, 2 * FOX_WIDTH:3 * FOX_WIDTH].multiply(DEEPNORM_BETA)
    ev_b_f = FORGET_BIAS_INIT + nrm(ks[3], (N_EVEN, FOX_HEADS), 0.1)
    ev_lambda_re = -0.5 + nrm(ks[4], (N_EVEN, SSM_GROUPS, SSM_STATE), 0.01)
    ev_lambda_im = (math.pi * jnp.arange(SSM_STATE, dtype=f32))[None, None, :] + nrm(
        ks[5], (N_EVEN, SSM_GROUPS, SSM_STATE), 0.01)
    ev_log_step = jax.random.uniform(ks[6], (N_EVEN, SSM_GROUPS), f32,
                                     minval=math.log(DT_MIN), maxval=math.log(DT_MAX))
    ev_ssm_b_re = nrm(ks[7], (N_EVEN, SSM_GROUPS, SSM_STATE, SSM_GROUP), (2 * SSM_GROUP) ** -0.5)
    ev_ssm_b_im = nrm(ks[8], (N_EVEN, SSM_GROUPS, SSM_STATE, SSM_GROUP), (2 * SSM_GROUP) ** -0.5)
    ev_ssm_c_re = nrm(ks[9], (N_EVEN, SSM_GROUPS, SSM_GROUP, SSM_STATE), (2 * SSM_STATE) ** -0.5)
    ev_ssm_c_im = nrm(ks[10], (N_EVEN, SSM_GROUPS, SSM_GROUP, SSM_STATE), (2 * SSM_STATE) ** -0.5)
    ev_ssm_d = nrm(ks[11], (N_EVEN, SSM_GROUPS, SSM_GROUP), 1.0)
    ev_w_glu = nrm(ks[12], (N_EVEN, SSM_WIDTH, 2 * SSM_WIDTH), SSM_WIDTH ** -0.5)
    ev_w_out = nrm(ks[13], (N_EVEN, D_MODEL, D_MODEL), D_MODEL ** -0.5 * DEEPNORM_BETA)

    od_w_in = nrm(ks[14], (N_ODD, D_MODEL, ODD_IN), D_MODEL ** -0.5)
    v_start = (SWA_HEADS + SWA_KV_HEADS) * SWA_HEAD_DIM
    od_w_in = od_w_in.at[:, :, v_start:].multiply(DEEPNORM_BETA)
    od_sinks = nrm(ks[15], (N_ODD, SWA_HEADS), 0.1)
    od_w_out = nrm(ks[16], (N_ODD, SWA_HEADS * SWA_HEAD_DIM, D_MODEL),
                   (SWA_HEADS * SWA_HEAD_DIM) ** -0.5 * DEEPNORM_BETA)

    ln_mix_g = 1.0 + nrm(ks[17], (DEPTH, D_MODEL), 0.02)
    ln_mix_b = nrm(ks[18], (DEPTH, D_MODEL), 0.02)
    ffn_w_up = nrm(ks[19], (DEPTH, D_MODEL, 2 * D_FF), D_MODEL ** -0.5)
    ffn_conv_w = nrm(ks[20], (DEPTH, CONV_WIDTH, 2 * D_FF), CONV_WIDTH ** -0.5)
    ffn_conv_b = nrm(ks[21], (DEPTH, 2 * D_FF), 0.02)
    ffn_w_down = nrm(ks[22], (DEPTH, D_FF, D_MODEL), D_FF ** -0.5 * DEEPNORM_BETA)
    ln_ffn_g = 1.0 + nrm(ks[23], (DEPTH, D_MODEL), 0.02)
    ln_ffn_b = nrm(ks[24], (DEPTH, D_MODEL), 0.02)

    return {'x': x, 'positions': positions,
            'ev_w_in': ev_w_in, 'ev_b_f': ev_b_f,
            'ev_lambda_re': ev_lambda_re, 'ev_lambda_im': ev_lambda_im, 'ev_log_step': ev_log_step,
            'ev_ssm_b_re': ev_ssm_b_re, 'ev_ssm_b_im': ev_ssm_b_im,
            'ev_ssm_c_re': ev_ssm_c_re, 'ev_ssm_c_im': ev_ssm_c_im, 'ev_ssm_d': ev_ssm_d,
            'ev_w_glu': ev_w_glu, 'ev_w_out': ev_w_out,
            'od_w_in': od_w_in, 'od_sinks': od_sinks, 'od_w_out': od_w_out,
            'ln_mix_g': ln_mix_g, 'ln_mix_b': ln_mix_b,
            'ffn_w_up': ffn_w_up, 'ffn_conv_w': ffn_conv_w, 'ffn_conv_b': ffn_conv_b,
            'ffn_w_down': ffn_w_down, 'ln_ffn_g': ln_ffn_g, 'ln_ffn_b': ln_ffn_b}


def reference(x, positions, ev_w_in, ev_b_f, ev_lambda_re, ev_lambda_im, ev_log_step,
              ev_ssm_b_re, ev_ssm_b_im, ev_ssm_c_re, ev_ssm_c_im, ev_ssm_d, ev_w_glu, ev_w_out,
              od_w_in, od_sinks, od_w_out, ln_mix_g, ln_mix_b,
              ffn_w_up, ffn_conv_w, ffn_conv_b, ffn_w_down, ln_ffn_g, ln_ffn_b):
    for i in range(DEPTH):
        j = i // 2
        if i % 2 == 0:
            mix = _even_mixer(x, ev_w_in[j], ev_b_f[j], ev_lambda_re[j], ev_lambda_im[j],
                              ev_log_step[j], ev_ssm_b_re[j], ev_ssm_b_im[j], ev_ssm_c_re[j],
                              ev_ssm_c_im[j], ev_ssm_d[j], ev_w_glu[j], ev_w_out[j])
        else:
            mix = _odd_mixer(x, positions, od_w_in[j], od_sinks[j], od_w_out[j])
        x = _layer_norm(DEEPNORM_ALPHA * x + mix, ln_mix_g[i], ln_mix_b[i])
        ffn = _conv_ffn(x, ffn_w_up[i], ffn_conv_w[i], ffn_conv_b[i], ffn_w_down[i])
        x = _layer_norm(DEEPNORM_ALPHA * x + ffn, ln_ffn_g[i], ln_ffn_b[i])
    return x
```

```cpp
#include <hip/hip_runtime.h>
#include <hip/hip_cooperative_groups.h>
#include <cstdio>
#include <cstdint>
namespace cg = cooperative_groups;

#define LAS __attribute__((address_space(3)))
#define DEV __device__ __forceinline__
typedef unsigned short bf16_t;
typedef short bf16x8 __attribute__((ext_vector_type(8)));
typedef short s16x4 __attribute__((ext_vector_type(4)));
typedef float f32x2 __attribute__((ext_vector_type(2)));
typedef float f32x4 __attribute__((ext_vector_type(4)));
typedef float f32x16 __attribute__((ext_vector_type(16)));
typedef unsigned u32x2 __attribute__((ext_vector_type(2)));
typedef unsigned u32x4 __attribute__((ext_vector_type(4)));
typedef __bf16 bf16x2_t __attribute__((ext_vector_type(2)));
typedef LAS unsigned char* ldsp;

constexpr int MTOK = 16384, DM = 2048, SEQ = 2048, NB = 8;
constexpr int DFF = 5504, NUP = 11008;
constexpr int EVEN_IN = 4104, ODD_IN = 2560;
constexpr float LN_EPS = 1e-5f;
constexpr float ALPHA = 1.4142135623730951f;
constexpr float LOG2E = 1.4426950408889634f;
constexpr float C2_FOX = 0.12751743082459868f;
constexpr float C2_SWA = 0.18033688011112042f;

constexpr size_t MiB = 1u << 20;
constexpr size_t WS_WIN0 = 0, WS_WGLU = 16 * MiB, WS_WOUT0 = 20 * MiB, WS_WIN1 = 28 * MiB, WS_WOUT1 = 38 * MiB;
constexpr size_t WS_WUP0 = 46 * MiB, WS_WUP1 = 89 * MiB, WS_WDN0 = 132 * MiB, WS_WDN1 = 154 * MiB;
constexpr size_t WS_XB = 176 * MiB;
constexpr size_t WS_ACTR = 240 * MiB;
constexpr size_t WS_QKV = WS_ACTR, WS_Y = WS_ACTR + 128 * MiB, WS_CAT = WS_ACTR + 160 * MiB, WS_ACT = WS_ACTR;
constexpr size_t WS_LOGF = 464 * MiB;
constexpr size_t WS_RAW = 465 * MiB;
constexpr size_t WS_END = 477 * MiB;

constexpr int LDS_BYTES = 147456;
constexpr int XCH_OFF = 131072;

DEV unsigned cvtpk(float lo, float hi) { f32x2 v = {lo, hi}; bf16x2_t b = __builtin_convertvector(v, bf16x2_t); return __builtin_bit_cast(unsigned, b); }
DEV float bf2f(unsigned short h) { return __builtin_bit_cast(float, (unsigned)h << 16); }
DEV float bflo(unsigned w) { return __builtin_bit_cast(float, w << 16); }
DEV float bfhi(unsigned w) { return __builtin_bit_cast(float, w & 0xffff0000u); }
DEV float fast_exp2(float x) { return __builtin_amdgcn_exp2f(x); }
DEV float fast_rcp(float x) { return __builtin_amdgcn_rcpf(x); }
DEV float sigmoidf_(float x) { return fast_rcp(1.0f + fast_exp2(-x * LOG2E)); }
DEV float siluf_(float x) { return x * sigmoidf_(x); }
DEV float gelu_tanh(float y) { const float u = 0.7978845608028654f * (y + 0.044715f * y * y * y); return y * fast_rcp(1.0f + fast_exp2(-2.0f * LOG2E * u)); }
template <int CTRL> DEV float dppf(float v) { return __builtin_bit_cast(float, __builtin_amdgcn_update_dpp(0, __builtin_bit_cast(int, v), CTRL, 0xf, 0xf, false)); }
DEV float wave_sum(float v) {
#pragma unroll
    for (int o = 1; o < 64; o <<= 1) v += __shfl_xor(v, o);
    return v;
}
#define LDS_WAIT() asm volatile("s_waitcnt lgkmcnt(0)" ::: "memory")
DEV int opaque_tid() { int t = threadIdx.x; asm volatile("" : "+v"(t)); return t; }

namespace pg8 {
constexpr int BM = 256, BK = 64, HALF = 128, HTB = HALF * BK * 2, STAGE_BYTES = 8 * HTB, NXCD = 8, WGM = 8;
__host__ __device__ __forceinline__ int lds_byte(int r, int c) { const int st = (r >> 4) * 2 + (c >> 5), rr = r & 15, cc = c & 31, ob = rr * 64 + cc * 2; return st * 1024 + (ob ^ (((ob >> 9) & 1) << 5)); }
__host__ __device__ __forceinline__ void stage_rc(int b, int& R, int& C) { const int st = b / 1024, sb = b % 1024, swz = sb ^ (((sb >> 9) & 1) << 5); R = (st >> 1) * 16 + swz / 64; C = (st & 1) * 32 + (swz % 64) / 2; }
__host__ __device__ __forceinline__ int perm32(int rho) { const int n = rho >> 4, i = rho & 15; return 8 * (i >> 2) + 4 * n + (i & 3); }
struct Unit { int pm, pn; };
struct Gemm { const bf16_t* A; const bf16_t* Bt; int M, N, K; };
struct StaticOrder {
    int nM, nN, nwg, G, c;
    __device__ void init(int M, int N, int G_, int c_) { nM = M / BM; nN = N / BM; nwg = nM * nN; G = G_; c = c_; }
    __device__ bool next(int i, Unit& u) const {
        const long L = (long)i * G + c; if (L >= nwg) return false;
        int wgid = (int)L; { const int q = nwg / NXCD, r = nwg % NXCD, xcd = wgid % NXCD, off = wgid / NXCD; wgid = (xcd < r ? xcd * (q + 1) : r * (q + 1) + (xcd - r) * q) + off; }
        const int nig = WGM * nN, gid = wgid / nig, fm = gid * WGM, gsz = (nM - fm) < WGM ? (nM - fm) : WGM;
        u.pm = fm + ((wgid % nig) % gsz); u.pn = (wgid % nig) / gsz; return true;
    }
};
typedef f32x4 Acc[2][2][4][2];

struct EpiBf16 {
    static constexpr bool PERM = true;
    bf16_t* O; int ldc; int scale_tiles; float scale0;
    DEV void operator()(Acc& acc, const Unit& u, int wr, int wc, int fr, int fq, ldsp) const {
        const int row0 = u.pm * BM + wr * 64 + fr; const int col0 = u.pn * BM + wc * 32 + 8 * fq;
        const float sc = (u.pn < scale_tiles) ? scale0 : 1.f;
#pragma unroll
        for (int ai = 0; ai < 2; ++ai)
#pragma unroll
            for (int m = 0; m < 4; ++m) { bf16_t* rowp = O + (size_t)(row0 + ai * HALF + m * 16) * ldc + col0;
#pragma unroll
                for (int bj = 0; bj < 2; ++bj) { const f32x4 v0 = acc[ai][bj][m][0] * sc, v1 = acc[ai][bj][m][1] * sc;
                    u32x4 w; w.x = cvtpk(v0[0], v0[1]); w.y = cvtpk(v0[2], v0[3]); w.z = cvtpk(v1[0], v1[1]); w.w = cvtpk(v1[2], v1[3]);
                    *(u32x4*)(rowp + bj * HALF) = w; } }
    }
};
struct EpiGlu {
    static constexpr bool PERM = true;
    bf16_t* O; int ldc;
    DEV void operator()(Acc& acc, const Unit& u, int wr, int wc, int fr, int fq, ldsp) const {
        const int row0 = u.pm * BM + wr * 64 + fr; const int col0 = u.pn * HALF + wc * 32 + 8 * fq;
#pragma unroll
        for (int ai = 0; ai < 2; ++ai)
#pragma unroll
            for (int m = 0; m < 4; ++m) { bf16_t* rowp = O + (size_t)(row0 + ai * HALF + m * 16) * ldc + col0;
                float r[8];
#pragma unroll
                for (int n = 0; n < 2; ++n)
#pragma unroll
                    for (int i = 0; i < 4; ++i) r[4 * n + i] = acc[ai][0][m][n][i] * sigmoidf_(acc[ai][1][m][n][i]);
                u32x4 w; w.x = cvtpk(r[0], r[1]); w.y = cvtpk(r[2], r[3]); w.z = cvtpk(r[4], r[5]); w.w = cvtpk(r[6], r[7]);
                *(u32x4*)rowp = w; }
    }
};
struct EpiRes {
    static constexpr bool PERM = false;
    const float* R; float* C;
    DEV void operator()(Acc& acc, const Unit& u, int wr, int wc, int fr, int fq, ldsp) const {
        const int row0 = u.pm * BM + wr * 64 + fr, col0 = u.pn * BM + wc * 32 + 4 * fq;
#pragma unroll
        for (int ai = 0; ai < 2; ++ai)
#pragma unroll
            for (int m = 0; m < 4; ++m) { const size_t off = (size_t)(row0 + ai * HALF + m * 16) * DM + col0;
                f32x4 rv[2][2];
#pragma unroll
                for (int bj = 0; bj < 2; ++bj)
#pragma unroll
                    for (int n = 0; n < 2; ++n) rv[bj][n] = *(const f32x4*)(R + off + bj * HALF + n * 16);
#pragma unroll
                for (int bj = 0; bj < 2; ++bj)
#pragma unroll
                    for (int n = 0; n < 2; ++n) *(f32x4*)(C + off + bj * HALF + n * 16) = rv[bj][n] * ALPHA + acc[ai][bj][m][n]; }
    }
};
struct EpiRope {
    static constexpr bool PERM = true;
    bf16_t* O; const int* pos;
    DEV void operator()(Acc& acc, const Unit& u, int wr, int wc, int fr, int fq, ldsp) const {
        const int row0 = u.pm * BM + wr * 64 + fr; const int col0 = u.pn * BM + wc * 32 + 8 * fq;
        const float sc = (u.pn < 8) ? C2_SWA : 1.f;
        const bool rope = (u.pn < 9) && ((wc & 1) == 0);
        constexpr float IFR[8] = {0.15915494309189535f, 0.03086376340470123f, 0.005985185712713705f, 0.001160663641240061f,
                                  0.00022507907903927653f, 4.364795279280289e-05f, 8.464330808241401e-06f, 1.6414262627950345e-06f};
#pragma unroll
        for (int ai = 0; ai < 2; ++ai)
#pragma unroll
            for (int m = 0; m < 4; ++m) { const int row = row0 + ai * HALF + m * 16; bf16_t* rowp = O + (size_t)row * ODD_IN + col0;
                float cs[8], sn[8];
                if (rope) { const float p = (float)pos[row];
#pragma unroll
                    for (int j = 0; j < 8; ++j) { float rev = p * IFR[j]; rev = rev - rintf(rev); cs[j] = __builtin_amdgcn_cosf(rev); sn[j] = __builtin_amdgcn_sinf(rev); } }
#pragma unroll
                for (int bj = 0; bj < 2; ++bj) { float r[8];
#pragma unroll
                    for (int n = 0; n < 2; ++n)
#pragma unroll
                        for (int i = 0; i < 4; ++i) { float v = acc[ai][bj][m][n][i];
                            if (rope) { const float o = __shfl_xor(v, 16); const int j = 4 * n + i;
                                const float rot = (fq == 0) ? (v * cs[j] - o * sn[j]) : (v * cs[j] + o * sn[j]);
                                v = (fq < 2) ? rot : v; }
                            r[4 * n + i] = v * sc; }
                    u32x4 w; w.x = cvtpk(r[0], r[1]); w.y = cvtpk(r[2], r[3]); w.z = cvtpk(r[4], r[5]); w.w = cvtpk(r[6], r[7]);
                    *(u32x4*)(rowp + bj * HALF) = w; } }
    }
};
struct EpiUp {
    static constexpr bool PERM = true;
    bf16_t* ACT; float* RAW; const float* cw; const float* cb;
    DEV void operator()(Acc& acc, const Unit& u, int wr, int wc, int fr, int fq, ldsp lds) const {
        LAS float* X = (LAS float*)(lds + XCH_OFF);
        const int cl0 = wc * 32 + 8 * fq;
        if (fr >= 14) {
#pragma unroll
            for (int ai = 0; ai < 2; ++ai)
#pragma unroll
                for (int bj = 0; bj < 2; ++bj)
#pragma unroll
                    for (int n = 0; n < 2; ++n) *(LAS f32x4*)(X + (((2 * ai + wr + 1) * 2 + (fr - 14)) * 256 + bj * HALF + cl0 + 4 * n)) = acc[ai][bj][3][n];
        }
        if (threadIdx.x < 128) *(LAS f32x4*)(X + 4 * threadIdx.x) = (f32x4){0.f, 0.f, 0.f, 0.f};
        if (wr == 0 && fr < 2) {
#pragma unroll
            for (int bj = 0; bj < 2; ++bj)
#pragma unroll
                for (int n = 0; n < 2; ++n) *(f32x4*)(RAW + ((size_t)(u.pm * 4 + fr) * NUP + u.pn * BM + bj * HALF + cl0 + 4 * n)) = acc[0][bj][0][n];
        }
        if (wr == 1 && fr >= 14) {
#pragma unroll
            for (int bj = 0; bj < 2; ++bj)
#pragma unroll
                for (int n = 0; n < 2; ++n) *(f32x4*)(RAW + ((size_t)(u.pm * 4 + 2 + (fr - 14)) * NUP + u.pn * BM + bj * HALF + cl0 + 4 * n)) = acc[1][bj][3][n];
        }
        asm volatile("s_waitcnt lgkmcnt(0)" ::: "memory"); __builtin_amdgcn_s_barrier(); asm volatile("" ::: "memory");
        const unsigned row0 = u.pm * BM + wr * 64 + fr;
#pragma unroll
        for (int ai = 0; ai < 2; ++ai) {
            const int s = 2 * ai + wr;
#pragma unroll
            for (int n = 0; n < 2; ++n) {
                const unsigned fg = u.pn * HALF + cl0 + 4 * n;
                f32x4 w0[2], w1[2], w2[2], bb[2];
#pragma unroll
                for (int bj = 0; bj < 2; ++bj) { const unsigned f = fg + (bj ? DFF : 0);
                    w0[bj] = *(const f32x4*)(cw + f); w1[bj] = *(const f32x4*)(cw + (NUP + f)); w2[bj] = *(const f32x4*)(cw + (2 * NUP + f)); bb[bj] = *(const f32x4*)(cb + f); }
#pragma unroll
                for (int m = 3; m >= 0; --m) {
                    float cv[2][4];
                    f32x4 bm1[2], bm2[2];
                    if (m == 0) {
                        asm volatile("" ::: "memory");
#pragma unroll
                        for (int bj = 0; bj < 2; ++bj) { bm2[bj] = *(LAS f32x4*)(X + ((s * 2 + 0) * 256 + bj * HALF + cl0 + 4 * n)); bm1[bj] = *(LAS f32x4*)(X + ((s * 2 + 1) * 256 + bj * HALF + cl0 + 4 * n)); }
                    }
#pragma unroll
                    for (int bj = 0; bj < 2; ++bj)
#pragma unroll
                        for (int i = 0; i < 4; ++i) {
                            const float cur = acc[ai][bj][m][n][i];
                            const float r1 = dppf<0x121>(cur), r2 = dppf<0x122>(cur);
                            float q1, q2;
                            if (m > 0) { const float pv = acc[ai][bj][m > 0 ? m - 1 : 0][n][i]; q1 = dppf<0x121>(pv); q2 = dppf<0x122>(pv); }
                            else { q1 = bm1[bj][i]; q2 = (fr == 1) ? bm1[bj][i] : bm2[bj][i]; }
                            const float p1 = (fr >= 1) ? r1 : q1, p2 = (fr >= 2) ? r2 : q2;
                            cv[bj][i] = bb[bj][i] + w0[bj][i] * p2 + w1[bj][i] * p1 + w2[bj][i] * cur;
                        }
                    u32x2 w; w.x = cvtpk(siluf_(cv[0][0]) * cv[1][0], siluf_(cv[0][1]) * cv[1][1]); w.y = cvtpk(siluf_(cv[0][2]) * cv[1][2], siluf_(cv[0][3]) * cv[1][3]);
                    *(u32x2*)(ACT + ((row0 + ai * HALF + m * 16) * (unsigned)DFF + fg)) = w;
                }
                asm volatile("" ::: "memory");
            }
        }
    }
};

template <class Epi>
DEV void gemm_phase(ldsp lds, const Gemm g, const StaticOrder& S, const Epi& E) {
    const int tid = opaque_tid(), wid = __builtin_amdgcn_readfirstlane(tid >> 6), lane = tid & 63, wr = wid >> 2, wc = wid & 3, fr = lane & 15, fq = lane >> 4;
    const int K = g.K, nt = K / BK;
    unsigned voffA[2], voffB[2];
#pragma unroll
    for (int i = 0; i < 2; ++i) { int R, C; stage_rc(tid * 16 + i * 8192, R, C); const int Rb = Epi::PERM ? ((R & ~31) + perm32(R & 31)) : R;
        voffA[i] = (unsigned)(R * K + C) * 2u; voffB[i] = (unsigned)(Rb * K + C) * 2u; }
    const size_t kstep = (size_t)(BK * 2);
    const size_t hstep = (size_t)HALF * K * 2;
    const size_t tstep = 2 * hstep;
    const unsigned ldsw = (unsigned)wid * 1024u;
    const int aoff = lds_byte(wr * 64 + fr, fq * 8), boff = lds_byte(wc * 32 + fr, fq * 8);
#define PG8_SA(b, h) (((b) * 2 + (h)) * HTB)
#define PG8_SB(b, h) ((4 + (b) * 2 + (h)) * HTB)
#define PG8_STAGE(bufoff, gbase, voff) do { _Pragma("unroll") for (int _i = 0; _i < 2; ++_i) \
        __builtin_amdgcn_global_load_lds((const unsigned*)((const char*)(gbase) + (voff)[_i]), (LAS unsigned*)(lds + (bufoff) + ldsw + _i * 8192), 16, 0, 0); } while (0)
#define PG8_LDA(dst, b, h) do { _Pragma("unroll") for (int m = 0; m < 4; ++m) _Pragma("unroll") for (int k = 0; k < 2; ++k) dst[m][k] = *(const LAS bf16x8*)(lds + PG8_SA(b, h) + aoff + m * 2048 + k * 1024); } while (0)
#define PG8_LDB(dst, b, h) do { _Pragma("unroll") for (int n = 0; n < 2; ++n) _Pragma("unroll") for (int k = 0; k < 2; ++k) dst[n][k] = *(const LAS bf16x8*)(lds + PG8_SB(b, h) + boff + n * 2048 + k * 1024); } while (0)
#define PG8_MMA(ai, bj, At, Bt) do { __builtin_amdgcn_s_setprio(1); _Pragma("unroll") for (int m = 0; m < 4; ++m) _Pragma("unroll") for (int n = 0; n < 2; ++n) _Pragma("unroll") for (int k = 0; k < 2; ++k) \
        acc[ai][bj][m][n] = __builtin_amdgcn_mfma_f32_16x16x32_bf16(Bt[n][k], At[m][k], acc[ai][bj][m][n], 0, 0, 0); __builtin_amdgcn_s_setprio(0); } while (0)
#define PG8_WAIT_V(n) asm volatile("s_waitcnt vmcnt(" #n ")" ::: "memory")
#define PG8_WAIT_L(n) asm volatile("s_waitcnt lgkmcnt(" #n ")" ::: "memory")
#define PG8_BAR __builtin_amdgcn_s_barrier()
#define PG8_SCHED __builtin_amdgcn_sched_barrier(0)
    Unit cur, nxt; int ui = 0;
    if (!S.next(0, cur)) return;
    Acc acc;
#pragma unroll
    for (int a = 0; a < 2; ++a)
#pragma unroll
        for (int b = 0; b < 2; ++b)
#pragma unroll
            for (int m = 0; m < 4; ++m)
#pragma unroll
                for (int n = 0; n < 2; ++n) acc[a][b][m][n] = (f32x4){0.f, 0.f, 0.f, 0.f};
    bf16x8 At[4][2], B0[2][2], B1[2][2];
    const char* cA = (const char*)g.A + (size_t)cur.pm * tstep; const char* cB = (const char*)g.Bt + (size_t)cur.pn * tstep;
    PG8_STAGE(PG8_SB(0, 0), cB, voffB); PG8_STAGE(PG8_SB(0, 1), cB + hstep, voffB); PG8_STAGE(PG8_SA(0, 0), cA, voffA); PG8_STAGE(PG8_SA(0, 1), cA + hstep, voffA);
    if (wr == 1) PG8_BAR;
    PG8_WAIT_V(2); PG8_BAR;
    PG8_STAGE(PG8_SB(1, 0), cB + kstep, voffB); PG8_STAGE(PG8_SA(1, 0), cA + kstep, voffA); PG8_STAGE(PG8_SB(1, 1), cB + hstep + kstep, voffB);
    PG8_WAIT_V(6); PG8_BAR;
    for (;;) {
        const bool has_next = S.next(ui + 1, nxt);
        const char* nA = has_next ? (const char*)g.A + (size_t)nxt.pm * tstep : cA; const char* nB = has_next ? (const char*)g.Bt + (size_t)nxt.pn * tstep : cB;
        for (int t = 0; t < nt; t += 2) {
            const bool last = (t == nt - 2);
            const char* a1 = cA + (size_t)(t + 1) * kstep;
            const char* a2 = last ? nA : cA + (size_t)(t + 2) * kstep; const char* b2 = last ? nB : cB + (size_t)(t + 2) * kstep;
            const char* a3 = a2 + kstep; const char* b3 = b2 + kstep;
            PG8_LDB(B0, 0, 0); PG8_LDB(B1, 0, 1); PG8_SCHED; PG8_LDA(At, 0, 0); PG8_STAGE(PG8_SA(1, 1), a1 + hstep, voffA);
            PG8_WAIT_V(8); PG8_WAIT_L(0); PG8_BAR; PG8_MMA(0, 0, At, B0); PG8_MMA(0, 1, At, B1); PG8_BAR; PG8_SCHED;
            PG8_LDA(At, 0, 1); PG8_STAGE(PG8_SB(0, 0), b2, voffB); PG8_STAGE(PG8_SB(0, 1), b2 + hstep, voffB); PG8_STAGE(PG8_SA(0, 0), a2, voffA);
            PG8_WAIT_V(8); PG8_WAIT_L(0); PG8_BAR; PG8_MMA(1, 0, At, B0); PG8_MMA(1, 1, At, B1); PG8_BAR; PG8_SCHED;
            PG8_LDB(B0, 1, 0); PG8_LDB(B1, 1, 1); PG8_SCHED; PG8_LDA(At, 1, 0); PG8_STAGE(PG8_SA(0, 1), a2 + hstep, voffA);
            PG8_WAIT_V(8); PG8_WAIT_L(0); PG8_BAR; PG8_MMA(0, 0, At, B0); PG8_MMA(0, 1, At, B1); PG8_BAR; PG8_SCHED;
            PG8_LDA(At, 1, 1); PG8_STAGE(PG8_SB(1, 0), b3, voffB); PG8_STAGE(PG8_SB(1, 1), b3 + hstep, voffB); PG8_STAGE(PG8_SA(1, 0), a3, voffA);
            PG8_WAIT_V(8); PG8_WAIT_L(0); PG8_BAR; PG8_MMA(1, 0, At, B0); PG8_MMA(1, 1, At, B1); PG8_BAR; PG8_SCHED;
        }
        if (wr == 0) PG8_BAR;
        E(acc, cur, wr, wc, fr, fq, lds);
        if (!has_next) break;
#pragma unroll
        for (int a = 0; a < 2; ++a)
#pragma unroll
            for (int b = 0; b < 2; ++b)
#pragma unroll
                for (int m = 0; m < 4; ++m)
#pragma unroll
                    for (int n = 0; n < 2; ++n) acc[a][b][m][n] = (f32x4){0.f, 0.f, 0.f, 0.f};
        cur = nxt; cA = nA; cB = nB; ++ui;
        if (wr == 1) PG8_BAR;
    }
    PG8_WAIT_V(0);
    PG8_BAR;
#undef PG8_SA
#undef PG8_SB
#undef PG8_STAGE
#undef PG8_LDA
#undef PG8_LDB
#undef PG8_MMA
#undef PG8_WAIT_V
#undef PG8_WAIT_L
#undef PG8_BAR
#undef PG8_SCHED
}
}

struct Args {
    const float* x; const int* pos;
    const float *ev_w_in, *ev_b_f, *lam_re, *lam_im, *log_step, *b_re, *b_im, *c_re, *c_im, *d_skip, *w_glu, *ev_w_out;
    const float *od_w_in, *od_sinks, *od_w_out, *ln_mix_g, *ln_mix_b, *w_up, *conv_w, *conv_b, *w_down, *ln_ffn_g, *ln_ffn_b;
    float* out; unsigned char* ws;
};

DEV void transpose_item(const float* __restrict__ W, int ldw, bf16_t* WT, int K, int n_dst0, int n_src0, int k0, LAS float* scr, int lane) {
#pragma unroll 8
    for (int i = 0; i < 32; ++i) { const int kk = 2 * i + (lane >> 5); scr[kk * 33 + (lane & 31)] = W[(size_t)(k0 + kk) * ldw + n_src0 + (lane & 31)]; }
    LDS_WAIT();
    const int c = lane & 7;
#pragma unroll
    for (int j = 0; j < 4; ++j) { const int n = (lane >> 3) + 8 * j; const LAS float* s = scr + (8 * c) * 33 + n;
        u32x4 o; o.x = cvtpk(s[0 * 33], s[1 * 33]); o.y = cvtpk(s[2 * 33], s[3 * 33]); o.z = cvtpk(s[4 * 33], s[5 * 33]); o.w = cvtpk(s[6 * 33], s[7 * 33]);
        *(u32x4*)(WT + (size_t)(n_dst0 + n) * K + k0 + 8 * c) = o; }
    LDS_WAIT();
}
DEV int glu_map(int n0, int half_off) { const int j = n0 >> 8, c = n0 & 255; return c < 128 ? 128 * j + c : half_off + 128 * j + (c - 128); }

DEV void phase_prologue(const Args& a, ldsp lds, int wave, int lane, int tid, int G) {
    unsigned char* ws = a.ws;
    LAS float* scr = (LAS float*)(lds + wave * 16384);
    const int gw = blockIdx.x * 8 + wave, NGW = G * 8;
    for (int it = gw; it < 44800; it += NGW) {
        int r = it;
        if (r < 4096) { const int kb = r / 128, nb = r % 128, n0 = 32 * nb; transpose_item(a.ev_w_in, EVEN_IN, (bf16_t*)(ws + WS_WIN0), 2048, n0, n0 < 3072 ? n0 : n0 + 8, 64 * kb, scr, lane); continue; } r -= 4096;
        if (r < 1024) { const int kb = r / 64, nb = r % 64, n0 = 32 * nb; transpose_item(a.w_glu, 2048, (bf16_t*)(ws + WS_WGLU), 1024, n0, glu_map(n0, 1024), 64 * kb, scr, lane); continue; } r -= 1024;
        if (r < 2048) { const int kb = r / 64, nb = r % 64, n0 = 32 * nb; transpose_item(a.ev_w_out, 2048, (bf16_t*)(ws + WS_WOUT0), 2048, n0, n0, 64 * kb, scr, lane); continue; } r -= 2048;
        if (r < 2560) { const int kb = r / 80, nb = r % 80, n0 = 32 * nb; transpose_item(a.od_w_in, ODD_IN, (bf16_t*)(ws + WS_WIN1), 2048, n0, n0, 64 * kb, scr, lane); continue; } r -= 2560;
        if (r < 2048) { const int kb = r / 64, nb = r % 64, n0 = 32 * nb; transpose_item(a.od_w_out, 2048, (bf16_t*)(ws + WS_WOUT1), 2048, n0, n0, 64 * kb, scr, lane); continue; } r -= 2048;
        if (r < 22016) { const int layer = r / 11008, r2 = r % 11008, kb = r2 / 344, nb = r2 % 344, n0 = 32 * nb;
            transpose_item(a.w_up + (size_t)layer * 2048 * NUP, NUP, (bf16_t*)(ws + (layer ? WS_WUP1 : WS_WUP0)), 2048, n0, glu_map(n0, DFF), 64 * kb, scr, lane); continue; } r -= 22016;
        { const int layer = r / 5504, r2 = r % 5504, kb = r2 / 64, nb = r2 % 64, n0 = 32 * nb;
            transpose_item(a.w_down + (size_t)layer * DFF * 2048, 2048, (bf16_t*)(ws + (layer ? WS_WDN1 : WS_WDN0)), DFF, n0, n0, 64 * kb, scr, lane); }
    }
    __syncthreads();
    LAS float* wf = (LAS float*)lds;
    for (int idx = tid; idx < 16384; idx += 512) { const int k = idx >> 3, h = idx & 7; wf[(((k & 3) * 512 + (k >> 2)) << 3) + h] = a.ev_w_in[(size_t)k * EVEN_IN + 3072 + h]; }
    __syncthreads();
    bf16_t* XB = (bf16_t*)(ws + WS_XB); float* LOGF = (float*)(ws + WS_LOGF);
    for (int row = gw; row < MTOK; row += NGW) {
        const f32x4* xr = (const f32x4*)(a.x + (size_t)row * DM) + lane;
        float dot[8];
#pragma unroll
        for (int h = 0; h < 8; ++h) dot[h] = 0.f;
#pragma unroll 1
        for (int j = 0; j < 8; ++j) { const f32x4 v = xr[64 * j];
            u32x2 o; o.x = cvtpk(v[0], v[1]); o.y = cvtpk(v[2], v[3]);
            *((u32x2*)(XB + (size_t)row * DM) + lane + 64 * j) = o;
#pragma unroll
            for (int e = 0; e < 4; ++e) { const LAS f32x4* wp = (const LAS f32x4*)(wf + ((e * 512 + lane + 64 * j) << 3)); const f32x4 wa = wp[0], wb = wp[1];
#pragma unroll
                for (int h = 0; h < 4; ++h) { dot[h] += v[e] * wa[h]; dot[4 + h] += v[e] * wb[h]; } } }
        float mine = 0.f;
#pragma unroll
        for (int h = 0; h < 8; ++h) { const float s = wave_sum(dot[h]); mine = (lane == h) ? s : mine; }
        if (lane < 8) { const float z = mine + a.ev_b_f[lane]; const float lf = fminf(z, 0.f) - logf(1.0f + expf(-fabsf(z))); LOGF[(size_t)row * 8 + lane] = lf; }
    }
}

DEV void phase_ln(const float* src, float* dst, bf16_t* xb, const float* g, const float* bt, int wave, int lane, int G) {
    const int gw = blockIdx.x * 8 + wave, NGW = G * 8;
    for (int row = gw; row < MTOK; row += NGW) {
        const f32x4* xr = (const f32x4*)(src + (size_t)row * DM) + lane;
        f32x4 v[8]; float s = 0.f;
#pragma unroll
        for (int j = 0; j < 8; ++j) { v[j] = xr[64 * j]; s += (v[j][0] + v[j][1]) + (v[j][2] + v[j][3]); }
        const float mean = wave_sum(s) * (1.f / DM); float s2 = 0.f;
#pragma unroll
        for (int j = 0; j < 8; ++j) { v[j] = v[j] - mean; s2 += (v[j][0] * v[j][0] + v[j][1] * v[j][1]) + (v[j][2] * v[j][2] + v[j][3] * v[j][3]); }
        const float rstd = 1.f / sqrtf(wave_sum(s2) * (1.f / DM) + LN_EPS);
#pragma unroll
        for (int j = 0; j < 8; ++j) { const f32x4 gg = *((const f32x4*)g + lane + 64 * j), bb = *((const f32x4*)bt + lane + 64 * j);
            const f32x4 y = v[j] * rstd * gg + bb;
            *((f32x4*)(dst + (size_t)row * DM) + lane + 64 * j) = y;
            if (xb) { u32x2 o; o.x = cvtpk(y[0], y[1]); o.y = cvtpk(y[2], y[3]); *((u32x2*)(xb + (size_t)row * DM) + lane + 64 * j) = o; } }
    }
}

DEV void phase_fixup(const float* RAW, bf16_t* ACT, const float* cw, const float* cb, int G) {
    const int NT = G * 512;
    for (int idx = blockIdx.x * 512 + opaque_tid(); idx < 64 * 2 * (DFF / 4); idx += NT) {
        const int f = (idx % (DFF / 4)) * 4, rr = (idx / (DFF / 4)) & 1, pm = idx / (2 * (DFF / 4));
        const int nl = 256 * (f >> 7) + (f & 127);
        float res[2][4];
#pragma unroll
        for (int gv = 0; gv < 2; ++gv) {
            const int nn = nl + gv * 128, ff = f + gv * DFF;
            const f32x4 c0 = *(const f32x4*)(RAW + (size_t)(pm * 4 + 0) * NUP + nn), c1 = *(const f32x4*)(RAW + (size_t)(pm * 4 + 1) * NUP + nn);
            f32x4 p2 = {0.f, 0.f, 0.f, 0.f}, p3 = {0.f, 0.f, 0.f, 0.f};
            if (pm & 7) { p2 = *(const f32x4*)(RAW + (size_t)((pm - 1) * 4 + 2) * NUP + nn); p3 = *(const f32x4*)(RAW + (size_t)((pm - 1) * 4 + 3) * NUP + nn); }
            const f32x4 w0 = *(const f32x4*)(cw + ff), w1 = *(const f32x4*)(cw + NUP + ff), w2 = *(const f32x4*)(cw + 2 * NUP + ff), bb = *(const f32x4*)(cb + ff);
            const f32x4 hm2 = rr ? p3 : p2, hm1 = rr ? c0 : p3, h0 = rr ? c1 : c0;
#pragma unroll
            for (int i = 0; i < 4; ++i) res[gv][i] = bb[i] + w0[i] * hm2[i] + w1[i] * hm1[i] + w2[i] * h0[i];
        }
        u32x2 o; o.x = cvtpk(siluf_(res[0][0]) * res[1][0], siluf_(res[0][1]) * res[1][1]); o.y = cvtpk(siluf_(res[0][2]) * res[1][2], siluf_(res[0][3]) * res[1][3]);
        *(u32x2*)(ACT + (size_t)(pm * 256 + rr) * DFF + f) = o;
    }
}

DEV void sincos_acc(float x, float& s, float& c) {
    const float k = rintf(x * 0.6366197723675814f);
    float r = fmaf(-k, 1.5707963705062866f, x); r = fmaf(-k, -4.371139006309477e-08f, r);
    const float r2 = r * r;
    const float sp = r + r * r2 * (-1.6666667e-1f + r2 * (8.3333333e-3f + r2 * (-1.9841270e-4f + r2 * 2.7557319e-6f)));
    const float cp = 1.0f + r2 * (-0.5f + r2 * (4.1666667e-2f + r2 * (-1.3888889e-3f + r2 * (2.4801587e-5f + r2 * -2.7557319e-7f))));
    const int q = ((int)k) & 3;
    s = (q == 0) ? sp : (q == 1) ? cp : (q == 2) ? -sp : -cp;
    c = (q == 0) ? cp : (q == 1) ? -sp : (q == 2) ? -cp : sp;
}
DEV void s5_wave(const Args& a, ldsp wl, int idx, int lane) {
    const int b = idx >> 6, g = idx & 63;
    const bf16_t* QKVU = (const bf16_t*)(a.ws + WS_QKV); bf16_t* Y = (bf16_t*)(a.ws + WS_Y);
    LAS float* BU = (LAS float*)wl;
    ldsp HB = wl + 18432;
    const float dt = expf(a.log_step[g]);
    const float lr = a.lam_re[g * 64 + lane], li = a.lam_im[g * 64 + lane];
    const float mag = expf(lr * dt); float sn, cs; sincos_acc(li * dt, sn, cs);
    const float ar = mag * cs, ai = mag * sn;
    const float den = lr * lr + li * li, xr = ar - 1.0f, xi = ai;
    const float gre = (xr * lr + xi * li) / den, gim = (xi * lr - xr * li) / den;
    const int hi = lane >> 5, c31 = lane & 31;
    bf16x8 Bf[4];
#pragma unroll
    for (int nb = 0; nb < 4; ++nb) { const int p2 = 32 * (nb & 1) + c31; const float gr = __shfl(gre, p2), gi = __shfl(gim, p2);
        const float* br = a.b_re + ((size_t)(g * 64 + p2) * 16 + 8 * hi); const float* bi = a.b_im + ((size_t)(g * 64 + p2) * 16 + 8 * hi);
        float v[8];
#pragma unroll
        for (int j = 0; j < 8; ++j) v[j] = (nb >> 1) ? (gr * bi[j] + gi * br[j]) : (gr * br[j] - gi * bi[j]);
        u32x4 w; w.x = cvtpk(v[0], v[1]); w.y = cvtpk(v[2], v[3]); w.z = cvtpk(v[4], v[5]); w.w = cvtpk(v[6], v[7]); Bf[nb] = __builtin_bit_cast(bf16x8, w); }
    const int c15 = lane & 15, kg = lane >> 4;
    bf16x8 Cf[4];
#pragma unroll
    for (int ks = 0; ks < 4; ++ks) { const f32x4 cr = *(const f32x4*)(a.c_re + ((size_t)(g * 16 + c15) * 64 + 16 * ks + 4 * kg)), ci = *(const f32x4*)(a.c_im + ((size_t)(g * 16 + c15) * 64 + 16 * ks + 4 * kg));
        u32x4 w; w.x = cvtpk(cr[0], -ci[0]); w.y = cvtpk(cr[1], -ci[1]); w.z = cvtpk(cr[2], -ci[2]); w.w = cvtpk(cr[3], -ci[3]); Cf[ks] = __builtin_bit_cast(bf16x8, w); }
    const f32x4 dsk = *(const f32x4*)(a.d_skip + g * 16 + 4 * kg);
    float hr = 0.f, him = 0.f;
    for (int blk = 0; blk < 64; ++blk) {
        const size_t tok0 = (size_t)b * SEQ + 32 * blk;
        const bf16x8 Uf = *(const bf16x8*)(QKVU + (tok0 + c31) * 4096 + 3072 + 16 * g + 8 * hi);
#pragma unroll
        for (int nb = 0; nb < 4; ++nb) {
            f32x16 z;
#pragma unroll
            for (int r = 0; r < 16; ++r) z[r] = 0.f;
            const f32x16 d = __builtin_amdgcn_mfma_f32_32x32x16_bf16(Uf, Bf[nb], z, 0, 0, 0);
            LAS float* dst = BU + (((nb >> 1) * 64 + 32 * (nb & 1) + c31) * 36 + 4 * hi);
#pragma unroll
            for (int q = 0; q < 4; ++q) *(LAS f32x4*)(dst + 8 * q) = (f32x4){d[4 * q], d[4 * q + 1], d[4 * q + 2], d[4 * q + 3]};
        }
        LDS_WAIT();
#pragma unroll
        for (int t4 = 0; t4 < 8; ++t4) {
            const f32x4 br = *(LAS f32x4*)(BU + (lane * 36 + 4 * t4)), bi = *(LAS f32x4*)(BU + ((64 + lane) * 36 + 4 * t4));
#pragma unroll
            for (int e = 0; e < 4; ++e) {
                const float nr = fmaf(-ai, him, fmaf(ar, hr, br[e])), ni = fmaf(ai, hr, fmaf(ar, him, bi[e]));
                hr = nr; him = ni;
                *(LAS unsigned*)(HB + (4 * t4 + e) * 272 + lane * 4) = cvtpk(hr, him);
            }
        }
        LDS_WAIT();
#pragma unroll
        for (int th = 0; th < 2; ++th) {
            f32x4 y = {0.f, 0.f, 0.f, 0.f};
#pragma unroll
            for (int ks = 0; ks < 4; ++ks) { const bf16x8 hf = *(LAS bf16x8*)(HB + (16 * th + c15) * 272 + 64 * ks + 16 * kg);
                y = __builtin_amdgcn_mfma_f32_16x16x32_bf16(Cf[ks], hf, y, 0, 0, 0); }
            const size_t tok = tok0 + 16 * th + c15;
            const u32x2 uu = *(const u32x2*)(QKVU + tok * 4096 + 3072 + 16 * g + 4 * kg);
            const float o0 = gelu_tanh(y[0] + dsk[0] * bflo(uu.x)), o1 = gelu_tanh(y[1] + dsk[1] * bfhi(uu.x));
            const float o2 = gelu_tanh(y[2] + dsk[2] * bflo(uu.y)), o3 = gelu_tanh(y[3] + dsk[3] * bfhi(uu.y));
            u32x2 o; o.x = cvtpk(o0, o1); o.y = cvtpk(o2, o3);
            *(u32x2*)(Y + tok * 1024 + 16 * g + 4 * kg) = o;
        }
        LDS_WAIT();
    }
}

DEV s16x4 vtr(ldsp p) { typedef short v4i16_t __attribute__((ext_vector_type(4))); return __builtin_bit_cast(s16x4, __builtin_amdgcn_ds_read_tr16_b64_v4i16((LAS v4i16_t*)p)); }
DEV int crow(int r, int hi) { return (r & 3) + 8 * (r >> 2) + 4 * hi; }

DEV void softmax_tile(f32x16& p0, f32x16& p1, float& m, float& l, float& alpha, bf16x8 (&pk)[4]) {
    float mx = fmaxf(p0[0], p1[0]);
#pragma unroll
    for (int r = 1; r < 16; ++r) mx = fmaxf(mx, fmaxf(p0[r], p1[r]));
    mx = fmaxf(mx, __shfl_xor(mx, 32));
    const float mn = fmaxf(m, mx);
    alpha = fast_exp2(m - mn); m = mn;
    float s = 0.f;
#pragma unroll
    for (int r = 0; r < 16; ++r) { p0[r] = fast_exp2(p0[r] - mn); p1[r] = fast_exp2(p1[r] - mn); s += p0[r] + p1[r]; }
    l = l * alpha + s;
#pragma unroll
    for (int sgrp = 0; sgrp < 4; ++sgrp) { const f32x16& p = (sgrp >> 1) ? p1 : p0; const int r0 = 8 * (sgrp & 1);
        u32x4 w; w.x = cvtpk(p[r0], p[r0 + 1]); w.y = cvtpk(p[r0 + 2], p[r0 + 3]); w.z = cvtpk(p[r0 + 4], p[r0 + 5]); w.w = cvtpk(p[r0 + 6], p[r0 + 7]);
        pk[sgrp] = __builtin_bit_cast(bf16x8, w); }
}

constexpr int FX_K0 = 0, FX_V0 = 32768, FX_CS = 65536, FX_WT = FX_CS + 8192;
DEV int fxs(int row) { return ((row & 3) << 2) | ((row >> 2) & 3); }
DEV void fox_unit(const Args& a, ldsp lds, int b, int h, int qb, int wave, int lane) {
    const bf16_t* QKVU = (const bf16_t*)(a.ws + WS_QKV); bf16_t* CAT = (bf16_t*)(a.ws + WS_CAT);
    const int hi = lane >> 5, c31 = lane & 31;
    const LAS float* cs = (const LAS float*)(lds + FX_CS);
    const int q0 = 256 * qb, qw0 = q0 + 32 * wave, qpos = qw0 + c31;
    const size_t rowb = (size_t)b * SEQ;
    bf16x8 qf[8];
#pragma unroll
    for (int d0 = 0; d0 < 8; ++d0) qf[d0] = *(const bf16x8*)(QKVU + (rowb + qpos) * 4096 + h * 128 + 16 * d0 + 8 * hi);
    const float cq = cs[qpos];
    f32x16 o[4];
#pragma unroll
    for (int db = 0; db < 4; ++db)
#pragma unroll
        for (int r = 0; r < 16; ++r) o[db][r] = 0.f;
    float m = -1e30f, l = 0.f;
    const int NT = 4 * (qb + 1);
    const int srow0 = 8 * wave + (lane >> 4), srow1 = srow0 + 4;
    const bf16_t* kg0 = QKVU + (rowb + srow0) * 4096 + 1024 + h * 128 + (((lane & 15) ^ fxs(srow0)) * 8);
    const bf16_t* kg1 = QKVU + (rowb + srow1) * 4096 + 1024 + h * 128 + (((lane & 15) ^ fxs(srow1)) * 8);
#define FOX_STAGE(kvrow0, buf) do { \
        __builtin_amdgcn_global_load_lds((const unsigned*)(kg0 + (size_t)(kvrow0) * 4096), (LAS unsigned*)(lds + FX_K0 + (buf) * 16384 + (2 * wave) * 1024), 16, 0, 0); \
        __builtin_amdgcn_global_load_lds((const unsigned*)(kg1 + (size_t)(kvrow0) * 4096), (LAS unsigned*)(lds + FX_K0 + (buf) * 16384 + (2 * wave + 1) * 1024), 16, 0, 0); \
        __builtin_amdgcn_global_load_lds((const unsigned*)(kg0 + (size_t)(kvrow0) * 4096 + 1024), (LAS unsigned*)(lds + FX_V0 + (buf) * 16384 + (2 * wave) * 1024), 16, 0, 0); \
        __builtin_amdgcn_global_load_lds((const unsigned*)(kg1 + (size_t)(kvrow0) * 4096 + 1024), (LAS unsigned*)(lds + FX_V0 + (buf) * 16384 + (2 * wave + 1) * 1024), 16, 0, 0); } while (0)
    FOX_STAGE(0, 0);
    asm volatile("s_waitcnt vmcnt(0)" ::: "memory");
    __syncthreads();
    const int i15 = lane & 15;
    const int fk = fxs(c31);
    const int vrow = 4 * hi + (i15 >> 2), vcl = 2 * ((lane >> 4) & 1) + ((i15 & 3) >> 1), vq = i15 >> 2;
    const int vlo_b = 256 * vrow + 16 * (vcl ^ hi) + 8 * (i15 & 1), vhi_b = 256 * (vrow + 8) + 16 * (vcl ^ (hi + 2)) + 8 * (i15 & 1);
    for (int j = 0; j < NT; ++j) {
        const int buf = j & 1, kv0 = 64 * j;
        if (j + 1 < NT) FOX_STAGE(kv0 + 64, buf ^ 1);
        if (kv0 <= qw0 + 31) {
            const ldsp KT = lds + FX_K0 + buf * 16384, VT = lds + FX_V0 + buf * 16384;
            f32x16 p0, p1;
#pragma unroll
            for (int gq = 0; gq < 4; ++gq) { const f32x4 c0 = *(const LAS f32x4*)(cs + kv0 + 8 * gq + 4 * hi), c1 = *(const LAS f32x4*)(cs + kv0 + 32 + 8 * gq + 4 * hi);
#pragma unroll
                for (int e = 0; e < 4; ++e) { p0[4 * gq + e] = cq - c0[e]; p1[4 * gq + e] = cq - c1[e]; } }
#pragma unroll
            for (int d0 = 0; d0 < 8; ++d0) {
                const int co = 16 * ((2 * d0 + hi) ^ fk);
                const bf16x8 ka = *(const LAS bf16x8*)(KT + c31 * 256 + co), kb = *(const LAS bf16x8*)(KT + (32 + c31) * 256 + co);
                p0 = __builtin_amdgcn_mfma_f32_32x32x16_bf16(ka, qf[d0], p0, 0, 0, 0); p1 = __builtin_amdgcn_mfma_f32_32x32x16_bf16(kb, qf[d0], p1, 0, 0, 0);
            }
            if (kv0 + 63 > qw0) {
#pragma unroll
                for (int r = 0; r < 16; ++r) { const int kv = kv0 + crow(r, hi); if (kv > qpos) p0[r] = -INFINITY; if (kv + 32 > qpos) p1[r] = -INFINITY; }
            }
            float alpha; bf16x8 pk[4];
            softmax_tile(p0, p1, m, l, alpha, pk);
#pragma unroll
            for (int db = 0; db < 4; ++db)
#pragma unroll
                for (int r = 0; r < 16; ++r) o[db][r] *= alpha;
#pragma unroll
            for (int db = 0; db < 4; ++db) {
                const int xo = 64 * (db ^ vq);
#pragma unroll
                for (int s = 0; s < 4; ++s) {
                    const s16x4 lo = vtr(VT + vlo_b + xo + s * 4096), hh = vtr(VT + vhi_b + xo + s * 4096);
                    const bf16x8 vf = {lo[0], lo[1], lo[2], lo[3], hh[0], hh[1], hh[2], hh[3]};
                    o[db] = __builtin_amdgcn_mfma_f32_32x32x16_bf16(vf, pk[s], o[db], 0, 0, 0);
                }
                __builtin_amdgcn_sched_barrier(0);
            }
        }
        asm volatile("s_waitcnt vmcnt(0)" ::: "memory");
        __syncthreads();
    }
#undef FOX_STAGE
    const float lt = l + __shfl_xor(l, 32); const float inv = 1.0f / lt;
    bf16_t* orow = CAT + (rowb + qpos) * DM + h * 128;
#pragma unroll
    for (int db = 0; db < 4; ++db)
#pragma unroll
        for (int gq = 0; gq < 4; ++gq) { u32x2 w; w.x = cvtpk(o[db][4 * gq] * inv, o[db][4 * gq + 1] * inv); w.y = cvtpk(o[db][4 * gq + 2] * inv, o[db][4 * gq + 3] * inv);
            *(u32x2*)(orow + 32 * db + 8 * gq + 4 * hi) = w; }
}
DEV void phase_fox_s5(const Args& a, ldsp lds, int wave, int lane, int tid) {
    if (wave < 2) s5_wave(a, lds + wave * 27136, blockIdx.x * 2 + wave, lane);
    __syncthreads();
    const int bh = blockIdx.x >> 2, s = blockIdx.x & 3, b = bh >> 3, h = bh & 7;
    {
        const float* LOGF = (const float*)(a.ws + WS_LOGF) + ((size_t)b * SEQ) * 8 + h;
        LAS float* cs = (LAS float*)(lds + FX_CS); LAS float* wt = (LAS float*)(lds + FX_WT);
        float v[4];
#pragma unroll
        for (int e = 0; e < 4; ++e) v[e] = LOGF[(size_t)(4 * tid + e) * 8];
        v[1] += v[0]; v[2] += v[1]; v[3] += v[2];
        float incl = v[3];
#pragma unroll
        for (int o = 1; o < 64; o <<= 1) { const float n = __shfl_up(incl, o); if (lane >= o) incl += n; }
        if (lane == 63) wt[wave] = incl;
        __syncthreads();
        float base = incl - v[3];
        for (int w = 0; w < wave; ++w) base += wt[w];
#pragma unroll
        for (int e = 0; e < 4; ++e) cs[4 * tid + e] = (base + v[e]) * LOG2E;
        __syncthreads();
    }
    fox_unit(a, lds, b, h, s, wave, lane);
    fox_unit(a, lds, b, h, 7 - s, wave, lane);
}

constexpr int SW_KP = 144, SW_VP = 192, SW_K0 = 0, SW_V0 = 256 * SW_KP;
DEV void swa_unit(const Args& a, ldsp lds, int u, int wave, int lane, int tid) {
    const bf16_t* QKV = (const bf16_t*)(a.ws + WS_QKV); bf16_t* CAT = (bf16_t*)(a.ws + WS_CAT);
    const int b = u >> 6, kvh = (u >> 4) & 3, n = u & 15, hi = lane >> 5, c31 = lane & 31;
    const size_t rowb = (size_t)b * SEQ;
    const int key0 = 128 * (n - 1);
#pragma unroll
    for (int i = 0; i < 4; ++i) { const int c = tid + 512 * i, row = c >> 3, ch = c & 7; const int key = key0 + row;
        if (key >= 0) { const bf16_t* src = QKV + (rowb + key) * ODD_IN + 2048 + kvh * 64 + ch * 8;
            *(LAS u32x4*)(lds + SW_K0 + row * SW_KP + ch * 16) = *(const u32x4*)src; *(LAS u32x4*)(lds + SW_V0 + row * SW_VP + ch * 16) = *(const u32x4*)(src + 256); } }
    __syncthreads();
    const int hq = 8 * kvh + wave;
    const float sink2 = a.od_sinks[hq] * LOG2E;
    const int i15 = lane & 15;
    const int vrd = (4 * hi + (i15 >> 2)) * SW_VP + (16 * ((lane >> 4) & 1) + 4 * (i15 & 3)) * 2;
    for (int sub = 0; sub < 4; ++sub) {
        const int ql = 128 + 32 * sub + c31;
        const size_t qrow = rowb + 128 * n + 32 * sub + c31;
        bf16x8 qf[4];
#pragma unroll
        for (int d0 = 0; d0 < 4; ++d0) qf[d0] = *(const bf16x8*)(QKV + qrow * ODD_IN + hq * 64 + 16 * d0 + 8 * hi);
        f32x16 o[2];
#pragma unroll
        for (int db = 0; db < 2; ++db)
#pragma unroll
            for (int r = 0; r < 16; ++r) o[db][r] = 0.f;
        float m = -1e30f, l = 0.f;
        const int T0 = sub >> 1;
        for (int T = T0; T < T0 + 3; ++T) {
            if (n == 0 && T < 2) continue;
            const ldsp KT = lds + SW_K0 + 64 * T * SW_KP, VT = lds + SW_V0 + 64 * T * SW_VP;
            f32x16 p0, p1;
#pragma unroll
            for (int r = 0; r < 16; ++r) { p0[r] = 0.f; p1[r] = 0.f; }
#pragma unroll
            for (int d0 = 0; d0 < 4; ++d0) {
                const bf16x8 ka = *(const LAS bf16x8*)(KT + c31 * SW_KP + (2 * d0 + hi) * 16), kb = *(const LAS bf16x8*)(KT + (32 + c31) * SW_KP + (2 * d0 + hi) * 16);
                p0 = __builtin_amdgcn_mfma_f32_32x32x16_bf16(ka, qf[d0], p0, 0, 0, 0); p1 = __builtin_amdgcn_mfma_f32_32x32x16_bf16(kb, qf[d0], p1, 0, 0, 0);
            }
#pragma unroll
            for (int r = 0; r < 16; ++r) { const int lr = 64 * T + crow(r, hi);
                if (lr > ql || lr <= ql - 128) p0[r] = -INFINITY;
                if (lr + 32 > ql || lr + 32 <= ql - 128) p1[r] = -INFINITY; }
            float alpha; bf16x8 pk[4];
            softmax_tile(p0, p1, m, l, alpha, pk);
#pragma unroll
            for (int db = 0; db < 2; ++db)
#pragma unroll
                for (int r = 0; r < 16; ++r) o[db][r] *= alpha;
#pragma unroll
            for (int db = 0; db < 2; ++db)
#pragma unroll
                for (int s = 0; s < 4; ++s) {
                    const s16x4 lo = vtr(VT + vrd + s * 16 * SW_VP + db * 64), hh = vtr(VT + vrd + (s * 16 + 8) * SW_VP + db * 64);
                    const bf16x8 vf = {lo[0], lo[1], lo[2], lo[3], hh[0], hh[1], hh[2], hh[3]};
                    o[db] = __builtin_amdgcn_mfma_f32_32x32x16_bf16(vf, pk[s], o[db], 0, 0, 0);
                }
        }
        const float M2 = fmaxf(m, sink2), f = fast_exp2(m - M2);
        const float lt = (l + __shfl_xor(l, 32)) * f + fast_exp2(sink2 - M2); const float inv = f / lt;
        bf16_t* orow = CAT + qrow * DM + hq * 64;
#pragma unroll
        for (int db = 0; db < 2; ++db)
#pragma unroll
            for (int gq = 0; gq < 4; ++gq) { u32x2 w; w.x = cvtpk(o[db][4 * gq] * inv, o[db][4 * gq + 1] * inv); w.y = cvtpk(o[db][4 * gq + 2] * inv, o[db][4 * gq + 3] * inv);
                *(u32x2*)(orow + 32 * db + 8 * gq + 4 * hi) = w; }
    }
    __syncthreads();
}

__global__ void __launch_bounds__(512, 2) fwd_megakernel(Args a) {
    extern __shared__ __attribute__((aligned(16))) unsigned char lds_raw[];
    cg::grid_group grid = cg::this_grid();
    const ldsp lds = (ldsp)lds_raw;
    const int G = gridDim.x;
    unsigned char* ws = a.ws;
    bf16_t* XB = (bf16_t*)(ws + WS_XB); bf16_t* QKV = (bf16_t*)(ws + WS_QKV); bf16_t* YB = (bf16_t*)(ws + WS_Y); bf16_t* CAT = (bf16_t*)(ws + WS_CAT); bf16_t* ACT = (bf16_t*)(ws + WS_ACT);
    float* RAW = (float*)(ws + WS_RAW);
    pg8::StaticOrder S;

    { const int tid = opaque_tid(); phase_prologue(a, lds, __builtin_amdgcn_readfirstlane(tid >> 6), tid & 63, tid, G); }
    grid.sync();
    { pg8::Gemm g{XB, (const bf16_t*)(ws + WS_WIN0), MTOK, 4096, 2048}; S.init(MTOK, 4096, G, blockIdx.x); pg8::EpiBf16 E{QKV, 4096, 4, C2_FOX}; pg8::gemm_phase(lds, g, S, E); }
    grid.sync();
    { const int tid = opaque_tid(); phase_fox_s5(a, lds, __builtin_amdgcn_readfirstlane(tid >> 6), tid & 63, tid); }
    grid.sync();
    { pg8::Gemm g{YB, (const bf16_t*)(ws + WS_WGLU), MTOK, 2048, 1024}; S.init(MTOK, 2048, G, blockIdx.x); pg8::EpiGlu E{CAT + 1024, DM}; pg8::gemm_phase(lds, g, S, E); }
    grid.sync();
    { pg8::Gemm g{CAT, (const bf16_t*)(ws + WS_WOUT0), MTOK, 2048, 2048}; S.init(MTOK, 2048, G, blockIdx.x); pg8::EpiRes E{a.x, a.out}; pg8::gemm_phase(lds, g, S, E); }
    grid.sync();
    { const int tid = opaque_tid(); phase_ln(a.out, a.out, XB, a.ln_mix_g, a.ln_mix_b, __builtin_amdgcn_readfirstlane(tid >> 6), tid & 63, G); }
    grid.sync();
    { pg8::Gemm g{XB, (const bf16_t*)(ws + WS_WUP0), MTOK, NUP, 2048}; S.init(MTOK, NUP, G, blockIdx.x); pg8::EpiUp E{ACT, RAW, a.conv_w, a.conv_b}; pg8::gemm_phase(lds, g, S, E); }
    grid.sync();
    phase_fixup(RAW, ACT, a.conv_w, a.conv_b, G);
    grid.sync();
    { pg8::Gemm g{ACT, (const bf16_t*)(ws + WS_WDN0), MTOK, 2048, DFF}; S.init(MTOK, 2048, G, blockIdx.x); pg8::EpiRes E{a.out, a.out}; pg8::gemm_phase(lds, g, S, E); }
    grid.sync();
    { const int tid = opaque_tid(); phase_ln(a.out, a.out, XB, a.ln_ffn_g, a.ln_ffn_b, __builtin_amdgcn_readfirstlane(tid >> 6), tid & 63, G); }
    grid.sync();
    { pg8::Gemm g{XB, (const bf16_t*)(ws + WS_WIN1), MTOK, ODD_IN, 2048}; S.init(MTOK, ODD_IN, G, blockIdx.x); pg8::EpiRope E{QKV, a.pos}; pg8::gemm_phase(lds, g, S, E); }
    grid.sync();
    { const int tid = opaque_tid(); for (int u = blockIdx.x; u < 512; u += G) swa_unit(a, lds, u, __builtin_amdgcn_readfirstlane(tid >> 6), tid & 63, tid); }
    grid.sync();
    { pg8::Gemm g{CAT, (const bf16_t*)(ws + WS_WOUT1), MTOK, 2048, 2048}; S.init(MTOK, 2048, G, blockIdx.x); pg8::EpiRes E{a.out, a.out}; pg8::gemm_phase(lds, g, S, E); }
    grid.sync();
    { const int tid = opaque_tid(); phase_ln(a.out, a.out, XB, a.ln_mix_g + DM, a.ln_mix_b + DM, __builtin_amdgcn_readfirstlane(tid >> 6), tid & 63, G); }
    grid.sync();
    { pg8::Gemm g{XB, (const bf16_t*)(ws + WS_WUP1), MTOK, NUP, 2048}; S.init(MTOK, NUP, G, blockIdx.x); pg8::EpiUp E{ACT, RAW, a.conv_w + 3 * NUP, a.conv_b + NUP}; pg8::gemm_phase(lds, g, S, E); }
    grid.sync();
    phase_fixup(RAW, ACT, a.conv_w + 3 * NUP, a.conv_b + NUP, G);
    grid.sync();
    { pg8::Gemm g{ACT, (const bf16_t*)(ws + WS_WDN1), MTOK, 2048, DFF}; S.init(MTOK, 2048, G, blockIdx.x); pg8::EpiRes E{a.out, a.out}; pg8::gemm_phase(lds, g, S, E); }
    grid.sync();
    { const int tid = opaque_tid(); phase_ln(a.out, a.out, nullptr, a.ln_ffn_g + DM, a.ln_ffn_b + DM, __builtin_amdgcn_readfirstlane(tid >> 6), tid & 63, G); }
}

extern "C" void kernel_launch(void* const* d_in, const int* in_sizes, int n_in, void* d_out, int out_size, void* d_ws, size_t ws_size, hipStream_t stream) {
    static int grid = 0;
    if (grid == 0) {
        if (n_in != 25 || out_size != MTOK * DM || ws_size < WS_END) { fprintf(stderr, "kernel_launch: unexpected shapes (n_in %d out %d ws %zu)\n", n_in, out_size, ws_size); grid = -1; return; }
        int dev = 0, cus = 0, per_cu = 0;
        (void)hipGetDevice(&dev); (void)hipDeviceGetAttribute(&cus, hipDeviceAttributeMultiprocessorCount, dev);
        if (hipFuncSetAttribute((const void*)fwd_megakernel, hipFuncAttributeMaxDynamicSharedMemorySize, LDS_BYTES) != hipSuccess) { fprintf(stderr, "kernel_launch: hipFuncSetAttribute failed\n"); grid = -1; return; }
        if (hipOccupancyMaxActiveBlocksPerMultiprocessor(&per_cu, (const void*)fwd_megakernel, 512, LDS_BYTES) != hipSuccess || per_cu < 1) { fprintf(stderr, "kernel_launch: occupancy query says %d blocks per CU\n", per_cu); per_cu = 1; }
        (void)hipGetLastError();
        grid = cus;
        if (grid > 256) grid = 256;
    }
    if (grid < 0) return;
    Args a{};
    a.x = (const float*)d_in[0]; a.pos = (const int*)d_in[1];
    a.ev_w_in = (const float*)d_in[2]; a.ev_b_f = (const float*)d_in[3]; a.lam_re = (const float*)d_in[4]; a.lam_im = (const float*)d_in[5]; a.log_step = (const float*)d_in[6];
    a.b_re = (const float*)d_in[7]; a.b_im = (const float*)d_in[8]; a.c_re = (const float*)d_in[9]; a.c_im = (const float*)d_in[10]; a.d_skip = (const float*)d_in[11];
    a.w_glu = (const float*)d_in[12]; a.ev_w_out = (const float*)d_in[13]; a.od_w_in = (const float*)d_in[14]; a.od_sinks = (const float*)d_in[15]; a.od_w_out = (const float*)d_in[16];
    a.ln_mix_g = (const float*)d_in[17]; a.ln_mix_b = (const float*)d_in[18]; a.w_up = (const float*)d_in[19]; a.conv_w = (const float*)d_in[20]; a.conv_b = (const float*)d_in[21];
    a.w_down = (const float*)d_in[22]; a.ln_ffn_g = (const float*)d_in[23]; a.ln_ffn_b = (const float*)d_in[24];
    a.out = (float*)d_out; a.ws = (unsigned char*)d_ws;
    void* args[] = {&a};
    hipError_t e = hipLaunchCooperativeKernel((const void*)fwd_megakernel, dim3(grid), dim3(512), args, LDS_BYTES, stream);
    if (e != hipSuccess) fprintf(stderr, "kernel_launch: cooperative launch failed: %s (grid %d)\n", hipGetErrorString(e), grid);
}
```

```cpp
#include <hip/hip_runtime.h>
#include <hip/hip_cooperative_groups.h>
#include <cstdio>
#include <cstdint>
namespace cg = cooperative_groups;

#define LAS __attribute__((address_space(3)))
#define DEV __device__ __forceinline__
typedef unsigned short bf16_t;
typedef short bf16x8 __attribute__((ext_vector_type(8)));
typedef short s16x4 __attribute__((ext_vector_type(4)));
typedef float f32x2 __attribute__((ext_vector_type(2)));
typedef float f32x4 __attribute__((ext_vector_type(4)));
typedef float f32x16 __attribute__((ext_vector_type(16)));
typedef unsigned u32x2 __attribute__((ext_vector_type(2)));
typedef unsigned u32x4 __attribute__((ext_vector_type(4)));
typedef __bf16 bf16x2_t __attribute__((ext_vector_type(2)));
typedef LAS unsigned char* ldsp;

constexpr int MTOK = 16384, DM = 2048, SEQ = 2048, NB = 8;
constexpr int DFF = 5504, NUP = 11008;
constexpr int EVEN_IN = 4104, ODD_IN = 2560;
constexpr float LN_EPS = 1e-5f;
constexpr float ALPHA = 1.4142135623730951f;
constexpr float LOG2E = 1.4426950408889634f;
constexpr float C2_FOX = 0.12751743082459868f;
constexpr float C2_SWA = 0.18033688011112042f;

constexpr size_t MiB = 1u << 20;
constexpr size_t WS_WIN0 = 0, WS_WGLU = 16 * MiB, WS_WOUT0 = 20 * MiB, WS_WIN1 = 28 * MiB, WS_WOUT1 = 38 * MiB;
constexpr size_t WS_WUP0 = 46 * MiB, WS_WUP1 = 89 * MiB, WS_WDN0 = 132 * MiB, WS_WDN1 = 154 * MiB;
constexpr size_t WS_XB = 176 * MiB;
constexpr size_t WS_ACTR = 240 * MiB;
constexpr size_t WS_QKV = WS_ACTR, WS_Y = WS_ACTR + 128 * MiB, WS_CAT = WS_ACTR + 160 * MiB, WS_ACT = WS_ACTR;
constexpr size_t WS_LOGF = 464 * MiB;
constexpr size_t WS_RAW = 465 * MiB;
constexpr size_t WS_BAR = 477 * MiB;
constexpr size_t WS_END = 478 * MiB;
constexpr int MISC_OFF = 143360;

constexpr int LDS_BYTES = 147456;
constexpr int XCH_OFF = 131072;

DEV unsigned cvtpk(float lo, float hi) { f32x2 v = {lo, hi}; bf16x2_t b = __builtin_convertvector(v, bf16x2_t); return __builtin_bit_cast(unsigned, b); }
DEV float bf2f(unsigned short h) { return __builtin_bit_cast(float, (unsigned)h << 16); }
DEV float bflo(unsigned w) { return __builtin_bit_cast(float, w << 16); }
DEV float bfhi(unsigned w) { return __builtin_bit_cast(float, w & 0xffff0000u); }
DEV float fast_exp2(float x) { return __builtin_amdgcn_exp2f(x); }
DEV float fast_rcp(float x) { return __builtin_amdgcn_rcpf(x); }
DEV float sigmoidf_(float x) { return fast_rcp(1.0f + fast_exp2(-x * LOG2E)); }
DEV float siluf_(float x) { return x * sigmoidf_(x); }
DEV float gelu_tanh(float y) { const float u = 0.7978845608028654f * (y + 0.044715f * y * y * y); return y * fast_rcp(1.0f + fast_exp2(-2.0f * LOG2E * u)); }
template <int CTRL> DEV float dppf(float v) { return __builtin_bit_cast(float, __builtin_amdgcn_update_dpp(0, __builtin_bit_cast(int, v), CTRL, 0xf, 0xf, false)); }
DEV float wave_sum(float v) {
#pragma unroll
    for (int o = 1; o < 64; o <<= 1) v += __shfl_xor(v, o);
    return v;
}
#define LDS_WAIT() asm volatile("s_waitcnt lgkmcnt(0)" ::: "memory")
DEV int opaque_tid() { int t = threadIdx.x; asm volatile("" : "+v"(t)); return t; }

namespace pg8 {
constexpr int BM = 256, BK = 64, HALF = 128, HTB = HALF * BK * 2, STAGE_BYTES = 8 * HTB, NXCD = 8, WGM = 8;
__host__ __device__ __forceinline__ int lds_byte(int r, int c) { const int st = (r >> 4) * 2 + (c >> 5), rr = r & 15, cc = c & 31, ob = rr * 64 + cc * 2; return st * 1024 + (ob ^ (((ob >> 9) & 1) << 5)); }
__host__ __device__ __forceinline__ void stage_rc(int b, int& R, int& C) { const int st = b / 1024, sb = b % 1024, swz = sb ^ (((sb >> 9) & 1) << 5); R = (st >> 1) * 16 + swz / 64; C = (st & 1) * 32 + (swz % 64) / 2; }
__host__ __device__ __forceinline__ int perm32(int rho) { const int n = rho >> 4, i = rho & 15; return 8 * (i >> 2) + 4 * n + (i & 3); }
struct Unit { int pm, pn; };
struct Gemm { const bf16_t* A; const bf16_t* Bt; int M, N, K; };
struct StaticOrder {
    int nM, nN, nwg, G, c;
    __device__ void init(int M, int N, int G_, int c_) { nM = M / BM; nN = N / BM; nwg = nM * nN; G = G_; c = c_; }
    __device__ bool next(int i, Unit& u) const {
        const long L = (long)i * G + c; if (L >= nwg) return false;
        int wgid = (int)L; { const int q = nwg / NXCD, r = nwg % NXCD, xcd = wgid % NXCD, off = wgid / NXCD; wgid = (xcd < r ? xcd * (q + 1) : r * (q + 1) + (xcd - r) * q) + off; }
        const int nig = WGM * nN, gid = wgid / nig, fm = gid * WGM, gsz = (nM - fm) < WGM ? (nM - fm) : WGM;
        u.pm = fm + ((wgid % nig) % gsz); u.pn = (wgid % nig) / gsz; return true;
    }
};
typedef f32x4 Acc[2][2][4][2];

struct EpiBf16 {
    static constexpr bool PERM = true;
    bf16_t* O; int ldc; int scale_tiles; float scale0;
    DEV void operator()(Acc& acc, const Unit& u, int wr, int wc, int fr, int fq, ldsp) const {
        const int row0 = u.pm * BM + wr * 64 + fr; const int col0 = u.pn * BM + wc * 32 + 8 * fq;
        const float sc = (u.pn < scale_tiles) ? scale0 : 1.f;
#pragma unroll
        for (int ai = 0; ai < 2; ++ai)
#pragma unroll
            for (int m = 0; m < 4; ++m) { bf16_t* rowp = O + (size_t)(row0 + ai * HALF + m * 16) * ldc + col0;
#pragma unroll
                for (int bj = 0; bj < 2; ++bj) { const f32x4 v0 = acc[ai][bj][m][0] * sc, v1 = acc[ai][bj][m][1] * sc;
                    u32x4 w; w.x = cvtpk(v0[0], v0[1]); w.y = cvtpk(v0[2], v0[3]); w.z = cvtpk(v1[0], v1[1]); w.w = cvtpk(v1[2], v1[3]);
                    *(u32x4*)(rowp + bj * HALF) = w; } }
    }
};
struct EpiGlu {
    static constexpr bool PERM = true;
    bf16_t* O; int ldc;
    DEV void operator()(Acc& acc, const Unit& u, int wr, int wc, int fr, int fq, ldsp) const {
        const int row0 = u.pm * BM + wr * 64 + fr; const int col0 = u.pn * HALF + wc * 32 + 8 * fq;
#pragma unroll
        for (int ai = 0; ai < 2; ++ai)
#pragma unroll
            for (int m = 0; m < 4; ++m) { bf16_t* rowp = O + (size_t)(row0 + ai * HALF + m * 16) * ldc + col0;
                float r[8];
#pragma unroll
                for (int n = 0; n < 2; ++n)
#pragma unroll
                    for (int i = 0; i < 4; ++i) r[4 * n + i] = acc[ai][0][m][n][i] * sigmoidf_(acc[ai][1][m][n][i]);
                u32x4 w; w.x = cvtpk(r[0], r[1]); w.y = cvtpk(r[2], r[3]); w.z = cvtpk(r[4], r[5]); w.w = cvtpk(r[6], r[7]);
                *(u32x4*)rowp = w; }
    }
};
struct EpiRes {
    static constexpr bool PERM = false;
    const float* R; float* C;
    DEV void operator()(Acc& acc, const Unit& u, int wr, int wc, int fr, int fq, ldsp) const {
        const int row0 = u.pm * BM + wr * 64 + fr, col0 = u.pn * BM + wc * 32 + 4 * fq;
#pragma unroll
        for (int ai = 0; ai < 2; ++ai)
#pragma unroll
            for (int m = 0; m < 4; ++m) { const size_t off = (size_t)(row0 + ai * HALF + m * 16) * DM + col0;
                f32x4 rv[2][2];
#pragma unroll
                for (int bj = 0; bj < 2; ++bj)
#pragma unroll
                    for (int n = 0; n < 2; ++n) rv[bj][n] = *(const f32x4*)(R + off + bj * HALF + n * 16);
#pragma unroll
                for (int bj = 0; bj < 2; ++bj)
#pragma unroll
                    for (int n = 0; n < 2; ++n) *(f32x4*)(C + off + bj * HALF + n * 16) = rv[bj][n] * ALPHA + acc[ai][bj][m][n]; }
    }
};
struct EpiRope {
    static constexpr bool PERM = true;
    bf16_t* O; const int* pos;
    DEV void operator()(Acc& acc, const Unit& u, int wr, int wc, int fr, int fq, ldsp) const {
        const int row0 = u.pm * BM + wr * 64 + fr; const int col0 = u.pn * BM + wc * 32 + 8 * fq;
        const float sc = (u.pn < 8) ? C2_SWA : 1.f;
        const bool rope = (u.pn < 9) && ((wc & 1) == 0);
        constexpr float IFR[8] = {0.15915494309189535f, 0.03086376340470123f, 0.005985185712713705f, 0.001160663641240061f,
                                  0.00022507907903927653f, 4.364795279280289e-05f, 8.464330808241401e-06f, 1.6414262627950345e-06f};
#pragma unroll
        for (int ai = 0; ai < 2; ++ai)
#pragma unroll
            for (int m = 0; m < 4; ++m) { const int row = row0 + ai * HALF + m * 16; bf16_t* rowp = O + (size_t)row * ODD_IN + col0;
                float cs[8], sn[8];
                if (rope) { const float p = (float)pos[row];
#pragma unroll
                    for (int j = 0; j < 8; ++j) { float rev = p * IFR[j]; rev = rev - rintf(rev); cs[j] = __builtin_amdgcn_cosf(rev); sn[j] = __builtin_amdgcn_sinf(rev); } }
#pragma unroll
                for (int bj = 0; bj < 2; ++bj) { float r[8];
#pragma unroll
                    for (int n = 0; n < 2; ++n)
#pragma unroll
                        for (int i = 0; i < 4; ++i) { float v = acc[ai][bj][m][n][i];
                            if (rope) { const float o = __shfl_xor(v, 16); const int j = 4 * n + i;
                                const float rot = (fq == 0) ? (v * cs[j] - o * sn[j]) : (v * cs[j] + o * sn[j]);
                                v = (fq < 2) ? rot : v; }
                            r[4 * n + i] = v * sc; }
                    u32x4 w; w.x = cvtpk(r[0], r[1]); w.y = cvtpk(r[2], r[3]); w.z = cvtpk(r[4], r[5]); w.w = cvtpk(r[6], r[7]);
                    *(u32x4*)(rowp + bj * HALF) = w; } }
    }
};
struct EpiUp {
    static constexpr bool PERM = true;
    bf16_t* ACT; float* RAW; const float* cw; const float* cb;
    DEV void operator()(Acc& acc, const Unit& u, int wr, int wc, int fr, int fq, ldsp lds) const {
        LAS float* X = (LAS float*)(lds + XCH_OFF);
        const int cl0 = wc * 32 + 8 * fq;
        if (fr >= 14) {
#pragma unroll
            for (int ai = 0; ai < 2; ++ai)
#pragma unroll
                for (int bj = 0; bj < 2; ++bj)
#pragma unroll
                    for (int n = 0; n < 2; ++n) *(LAS f32x4*)(X + (((2 * ai + wr + 1) * 2 + (fr - 14)) * 256 + bj * HALF + cl0 + 4 * n)) = acc[ai][bj][3][n];
        }
        if (threadIdx.x < 128) *(LAS f32x4*)(X + 4 * threadIdx.x) = (f32x4){0.f, 0.f, 0.f, 0.f};
        if (wr == 0 && fr < 2) {
#pragma unroll
            for (int bj = 0; bj < 2; ++bj)
#pragma unroll
                for (int n = 0; n < 2; ++n) *(f32x4*)(RAW + ((size_t)(u.pm * 4 + fr) * NUP + u.pn * BM + bj * HALF + cl0 + 4 * n)) = acc[0][bj][0][n];
        }
        if (wr == 1 && fr >= 14) {
#pragma unroll
            for (int bj = 0; bj < 2; ++bj)
#pragma unroll
                for (int n = 0; n < 2; ++n) *(f32x4*)(RAW + ((size_t)(u.pm * 4 + 2 + (fr - 14)) * NUP + u.pn * BM + bj * HALF + cl0 + 4 * n)) = acc[1][bj][3][n];
        }
        asm volatile("s_waitcnt lgkmcnt(0)" ::: "memory"); __builtin_amdgcn_s_barrier(); asm volatile("" ::: "memory");
        const unsigned row0 = u.pm * BM + wr * 64 + fr;
#pragma unroll
        for (int ai = 0; ai < 2; ++ai) {
            const int s = 2 * ai + wr;
#pragma unroll
            for (int n = 0; n < 2; ++n) {
                const unsigned fg = u.pn * HALF + cl0 + 4 * n;
                f32x4 w0[2], w1[2], w2[2], bb[2];
#pragma unroll
                for (int bj = 0; bj < 2; ++bj) { const unsigned f = fg + (bj ? DFF : 0);
                    w0[bj] = *(const f32x4*)(cw + f); w1[bj] = *(const f32x4*)(cw + (NUP + f)); w2[bj] = *(const f32x4*)(cw + (2 * NUP + f)); bb[bj] = *(const f32x4*)(cb + f); }
#pragma unroll
                for (int m = 3; m >= 0; --m) {
                    float cv[2][4];
                    f32x4 bm1[2], bm2[2];
                    if (m == 0) {
                        asm volatile("" ::: "memory");
#pragma unroll
                        for (int bj = 0; bj < 2; ++bj) { bm2[bj] = *(LAS f32x4*)(X + ((s * 2 + 0) * 256 + bj * HALF + cl0 + 4 * n)); bm1[bj] = *(LAS f32x4*)(X + ((s * 2 + 1) * 256 + bj * HALF + cl0 + 4 * n)); }
                    }
#pragma unroll
                    for (int bj = 0; bj < 2; ++bj)
#pragma unroll
                        for (int i = 0; i < 4; ++i) {
                            const float cur = acc[ai][bj][m][n][i];
                            const float r1 = dppf<0x121>(cur), r2 = dppf<0x122>(cur);
                            float q1, q2;
                            if (m > 0) { const float pv = acc[ai][bj][m > 0 ? m - 1 : 0][n][i]; q1 = dppf<0x121>(pv); q2 = dppf<0x122>(pv); }
                            else { q1 = bm1[bj][i]; q2 = (fr == 1) ? bm1[bj][i] : bm2[bj][i]; }
                            const float p1 = (fr >= 1) ? r1 : q1, p2 = (fr >= 2) ? r2 : q2;
                            cv[bj][i] = bb[bj][i] + w0[bj][i] * p2 + w1[bj][i] * p1 + w2[bj][i] * cur;
                        }
                    u32x2 w; w.x = cvtpk(siluf_(cv[0][0]) * cv[1][0], siluf_(cv[0][1]) * cv[1][1]); w.y = cvtpk(siluf_(cv[0][2]) * cv[1][2], siluf_(cv[0][3]) * cv[1][3]);
                    *(u32x2*)(ACT + ((row0 + ai * HALF + m * 16) * (unsigned)DFF + fg)) = w;
                }
                asm volatile("" ::: "memory");
            }
        }
    }
};

template <class Epi>
DEV void gemm_phase(ldsp lds, const Gemm g, const StaticOrder& S, const Epi& E) {
    const int tid = opaque_tid(), wid = __builtin_amdgcn_readfirstlane(tid >> 6), lane = tid & 63, wr = wid >> 2, wc = wid & 3, fr = lane & 15, fq = lane >> 4;
    const int K = g.K, nt = K / BK;
    unsigned voffA[2], voffB[2];
#pragma unroll
    for (int i = 0; i < 2; ++i) { int R, C; stage_rc(tid * 16 + i * 8192, R, C); const int Rb = Epi::PERM ? ((R & ~31) + perm32(R & 31)) : R;
        voffA[i] = (unsigned)(R * K + C) * 2u; voffB[i] = (unsigned)(Rb * K + C) * 2u; }
    const size_t kstep = (size_t)(BK * 2);
    const size_t hstep = (size_t)HALF * K * 2;
    const size_t tstep = 2 * hstep;
    const unsigned ldsw = (unsigned)wid * 1024u;
    const int aoff = lds_byte(wr * 64 + fr, fq * 8), boff = lds_byte(wc * 32 + fr, fq * 8);
#define PG8_SA(b, h) (((b) * 2 + (h)) * HTB)
#define PG8_SB(b, h) ((4 + (b) * 2 + (h)) * HTB)
#define PG8_STAGE(bufoff, gbase, voff) do { _Pragma("unroll") for (int _i = 0; _i < 2; ++_i) \
        __builtin_amdgcn_global_load_lds((const unsigned*)((const char*)(gbase) + (voff)[_i]), (LAS unsigned*)(lds + (bufoff) + ldsw + _i * 8192), 16, 0, 0); } while (0)
#define PG8_LDA(dst, b, h) do { _Pragma("unroll") for (int m = 0; m < 4; ++m) _Pragma("unroll") for (int k = 0; k < 2; ++k) dst[m][k] = *(const LAS bf16x8*)(lds + PG8_SA(b, h) + aoff + m * 2048 + k * 1024); } while (0)
#define PG8_LDB(dst, b, h) do { _Pragma("unroll") for (int n = 0; n < 2; ++n) _Pragma("unroll") for (int k = 0; k < 2; ++k) dst[n][k] = *(const LAS bf16x8*)(lds + PG8_SB(b, h) + boff + n * 2048 + k * 1024); } while (0)
#define PG8_MMA(ai, bj, At, Bt) do { __builtin_amdgcn_s_setprio(1); _Pragma("unroll") for (int m = 0; m < 4; ++m) _Pragma("unroll") for (int n = 0; n < 2; ++n) _Pragma("unroll") for (int k = 0; k < 2; ++k) \
        acc[ai][bj][m][n] = __builtin_amdgcn_mfma_f32_16x16x32_bf16(Bt[n][k], At[m][k], acc[ai][bj][m][n], 0, 0, 0); __builtin_amdgcn_s_setprio(0); } while (0)
#define PG8_WAIT_V(n) asm volatile("s_waitcnt vmcnt(" #n ")" ::: "memory")
#define PG8_WAIT_L(n) asm volatile("s_waitcnt lgkmcnt(" #n ")" ::: "memory")
#define PG8_BAR __builtin_amdgcn_s_barrier()
#define PG8_SCHED __builtin_amdgcn_sched_barrier(0)
    Unit cur, nxt; int ui = 0;
    if (!S.next(0, cur)) return;
    Acc acc;
#pragma unroll
    for (int a = 0; a < 2; ++a)
#pragma unroll
        for (int b = 0; b < 2; ++b)
#pragma unroll
            for (int m = 0; m < 4; ++m)
#pragma unroll
                for (int n = 0; n < 2; ++n) acc[a][b][m][n] = (f32x4){0.f, 0.f, 0.f, 0.f};
    bf16x8 At[4][2], B0[2][2], B1[2][2];
    const char* cA = (const char*)g.A + (size_t)cur.pm * tstep; const char* cB = (const char*)g.Bt + (size_t)cur.pn * tstep;
    PG8_STAGE(PG8_SB(0, 0), cB, voffB); PG8_STAGE(PG8_SB(0, 1), cB + hstep, voffB); PG8_STAGE(PG8_SA(0, 0), cA, voffA); PG8_STAGE(PG8_SA(0, 1), cA + hstep, voffA);
    if (wr == 1) PG8_BAR;
    PG8_WAIT_V(2); PG8_BAR;
    PG8_STAGE(PG8_SB(1, 0), cB + kstep, voffB); PG8_STAGE(PG8_SA(1, 0), cA + kstep, voffA); PG8_STAGE(PG8_SB(1, 1), cB + hstep + kstep, voffB);
    PG8_WAIT_V(6); PG8_BAR;
    for (;;) {
        const bool has_next = S.next(ui + 1, nxt);
        const char* nA = has_next ? (const char*)g.A + (size_t)nxt.pm * tstep : cA; const char* nB = has_next ? (const char*)g.Bt + (size_t)nxt.pn * tstep : cB;
        for (int t = 0; t < nt; t += 2) {
            const bool last = (t == nt - 2);
            const char* a1 = cA + (size_t)(t + 1) * kstep;
            const char* a2 = last ? nA : cA + (size_t)(t + 2) * kstep; const char* b2 = last ? nB : cB + (size_t)(t + 2) * kstep;
            const char* a3 = a2 + kstep; const char* b3 = b2 + kstep;
            PG8_LDB(B0, 0, 0); PG8_LDB(B1, 0, 1); PG8_SCHED; PG8_LDA(At, 0, 0); PG8_STAGE(PG8_SA(1, 1), a1 + hstep, voffA);
            PG8_WAIT_V(8); PG8_WAIT_L(0); PG8_BAR; PG8_MMA(0, 0, At, B0); PG8_MMA(0, 1, At, B1); PG8_BAR; PG8_SCHED;
            PG8_LDA(At, 0, 1); PG8_STAGE(PG8_SB(0, 0), b2, voffB); PG8_STAGE(PG8_SB(0, 1), b2 + hstep, voffB); PG8_STAGE(PG8_SA(0, 0), a2, voffA);
            PG8_WAIT_V(8); PG8_WAIT_L(0); PG8_BAR; PG8_MMA(1, 0, At, B0); PG8_MMA(1, 1, At, B1); PG8_BAR; PG8_SCHED;
            PG8_LDB(B0, 1, 0); PG8_LDB(B1, 1, 1); PG8_SCHED; PG8_LDA(At, 1, 0); PG8_STAGE(PG8_SA(0, 1), a2 + hstep, voffA);
            PG8_WAIT_V(8); PG8_WAIT_L(0); PG8_BAR; PG8_MMA(0, 0, At, B0); PG8_MMA(0, 1, At, B1); PG8_BAR; PG8_SCHED;
            PG8_LDA(At, 1, 1); PG8_STAGE(PG8_SB(1, 0), b3, voffB); PG8_STAGE(PG8_SB(1, 1), b3 + hstep, voffB); PG8_STAGE(PG8_SA(1, 0), a3, voffA);
            PG8_WAIT_V(8); PG8_WAIT_L(0); PG8_BAR; PG8_MMA(1, 0, At, B0); PG8_MMA(1, 1, At, B1); PG8_BAR; PG8_SCHED;
        }
        if (wr == 0) PG8_BAR;
        E(acc, cur, wr, wc, fr, fq, lds);
        if (!has_next) break;
#pragma unroll
        for (int a = 0; a < 2; ++a)
#pragma unroll
            for (int b = 0; b < 2; ++b)
#pragma unroll
                for (int m = 0; m < 4; ++m)
#pragma unroll
                    for (int n = 0; n < 2; ++n) acc[a][b][m][n] = (f32x4){0.f, 0.f, 0.f, 0.f};
        cur = nxt; cA = nA; cB = nB; ++ui;
        if (wr == 1) PG8_BAR;
    }
    PG8_WAIT_V(0);
    PG8_BAR;
#undef PG8_SA
#undef PG8_SB
#undef PG8_STAGE
#undef PG8_LDA
#undef PG8_LDB
#undef PG8_MMA
#undef PG8_WAIT_V
#undef PG8_WAIT_L
#undef PG8_BAR
#undef PG8_SCHED
}
}

struct Args {
    const float* x; const int* pos;
    const float *ev_w_in, *ev_b_f, *lam_re, *lam_im, *log_step, *b_re, *b_im, *c_re, *c_im, *d_skip, *w_glu, *ev_w_out;
    const float *od_w_in, *od_sinks, *od_w_out, *ln_mix_g, *ln_mix_b, *w_up, *conv_w, *conv_b, *w_down, *ln_ffn_g, *ln_ffn_b;
    float* out; unsigned char* ws;
};

DEV void transpose_item(const float* __restrict__ W, int ldw, bf16_t* WT, int K, int n_dst0, int n_src0, int k0, LAS float* scr, int lane) {
    float tv[32];
#pragma unroll
    for (int i = 0; i < 32; ++i) { const int kk = 2 * i + (lane >> 5); tv[i] = W[(size_t)(k0 + kk) * ldw + n_src0 + (lane & 31)]; }
#pragma unroll
    for (int i = 0; i < 32; ++i) { const int kk = 2 * i + (lane >> 5); scr[kk * 33 + (lane & 31)] = tv[i]; }
    LDS_WAIT();
    const int c = lane & 7;
#pragma unroll
    for (int j = 0; j < 4; ++j) { const int n = (lane >> 3) + 8 * j; const LAS float* s = scr + (8 * c) * 33 + n;
        u32x4 o; o.x = cvtpk(s[0 * 33], s[1 * 33]); o.y = cvtpk(s[2 * 33], s[3 * 33]); o.z = cvtpk(s[4 * 33], s[5 * 33]); o.w = cvtpk(s[6 * 33], s[7 * 33]);
        *(u32x4*)(WT + (size_t)(n_dst0 + n) * K + k0 + 8 * c) = o; }
    LDS_WAIT();
}
DEV int glu_map(int n0, int half_off) { const int j = n0 >> 8, c = n0 & 255; return c < 128 ? 128 * j + c : half_off + 128 * j + (c - 128); }

DEV void phase_prologue(const Args& a, ldsp lds, int wave, int lane, int tid, int G) {
    unsigned char* ws = a.ws;
    LAS float* scr = (LAS float*)(lds + wave * 16384);
    const int gw = blockIdx.x * 8 + wave, NGW = G * 8;
    for (int it = gw; it < 44800; it += NGW) {
        int r = it;
        if (r < 4096) { const int kb = r / 128, nb = r % 128, n0 = 32 * nb; transpose_item(a.ev_w_in, EVEN_IN, (bf16_t*)(ws + WS_WIN0), 2048, n0, n0 < 3072 ? n0 : n0 + 8, 64 * kb, scr, lane); continue; } r -= 4096;
        if (r < 1024) { const int kb = r / 64, nb = r % 64, n0 = 32 * nb; transpose_item(a.w_glu, 2048, (bf16_t*)(ws + WS_WGLU), 1024, n0, glu_map(n0, 1024), 64 * kb, scr, lane); continue; } r -= 1024;
        if (r < 2048) { const int kb = r / 64, nb = r % 64, n0 = 32 * nb; transpose_item(a.ev_w_out, 2048, (bf16_t*)(ws + WS_WOUT0), 2048, n0, n0, 64 * kb, scr, lane); continue; } r -= 2048;
        if (r < 2560) { const int kb = r / 80, nb = r % 80, n0 = 32 * nb; transpose_item(a.od_w_in, ODD_IN, (bf16_t*)(ws + WS_WIN1), 2048, n0, n0, 64 * kb, scr, lane); continue; } r -= 2560;
        if (r < 2048) { const int kb = r / 64, nb = r % 64, n0 = 32 * nb; transpose_item(a.od_w_out, 2048, (bf16_t*)(ws + WS_WOUT1), 2048, n0, n0, 64 * kb, scr, lane); continue; } r -= 2048;
        if (r < 22016) { const int layer = r / 11008, r2 = r % 11008, kb = r2 / 344, nb = r2 % 344, n0 = 32 * nb;
            transpose_item(a.w_up + (size_t)layer * 2048 * NUP, NUP, (bf16_t*)(ws + (layer ? WS_WUP1 : WS_WUP0)), 2048, n0, glu_map(n0, DFF), 64 * kb, scr, lane); continue; } r -= 22016;
        { const int layer = r / 5504, r2 = r % 5504, kb = r2 / 64, nb = r2 % 64, n0 = 32 * nb;
            transpose_item(a.w_down + (size_t)layer * DFF * 2048, 2048, (bf16_t*)(ws + (layer ? WS_WDN1 : WS_WDN0)), DFF, n0, n0, 64 * kb, scr, lane); }
    }
    __syncthreads();
    LAS float* wf = (LAS float*)lds;
    for (int idx = tid; idx < 16384; idx += 512) { const int k = idx >> 3, h = idx & 7; wf[(((k & 3) * 512 + (k >> 2)) << 3) + h] = a.ev_w_in[(size_t)k * EVEN_IN + 3072 + h]; }
    __syncthreads();
    bf16_t* XB = (bf16_t*)(ws + WS_XB); float* LOGF = (float*)(ws + WS_LOGF);
    for (int row = gw; row < MTOK; row += NGW) {
        const f32x4* xr = (const f32x4*)(a.x + (size_t)row * DM) + lane;
        float dot[8];
#pragma unroll
        for (int h = 0; h < 8; ++h) dot[h] = 0.f;
        f32x4 xv[8];
#pragma unroll
        for (int j = 0; j < 8; ++j) xv[j] = xr[64 * j];
        asm volatile("" ::: "memory");
#pragma unroll
        for (int j = 0; j < 8; ++j) { const f32x4 v = xv[j]; asm volatile("" ::: "memory");
            u32x2 o; o.x = cvtpk(v[0], v[1]); o.y = cvtpk(v[2], v[3]);
            *((u32x2*)(XB + (size_t)row * DM) + lane + 64 * j) = o;
#pragma unroll
            for (int e = 0; e < 4; ++e) { const LAS f32x4* wp = (const LAS f32x4*)(wf + ((e * 512 + lane + 64 * j) << 3)); const f32x4 wa = wp[0], wb = wp[1];
#pragma unroll
                for (int h = 0; h < 4; ++h) { dot[h] += v[e] * wa[h]; dot[4 + h] += v[e] * wb[h]; } } }
        float mine = 0.f;
#pragma unroll
        for (int h = 0; h < 8; ++h) { const float s = wave_sum(dot[h]); mine = (lane == h) ? s : mine; }
        if (lane < 8) { const float z = mine + a.ev_b_f[lane]; const float lf = fminf(z, 0.f) - logf(1.0f + expf(-fabsf(z))); LOGF[(size_t)row * 8 + lane] = lf; }
    }
}

DEV void phase_ln(const float* src, float* dst, bf16_t* xb, const float* g, const float* bt, int wave, int lane, int G) {
    const int gw = blockIdx.x * 8 + wave, NGW = G * 8;
    for (int row = gw; row < MTOK; row += NGW) {
        const f32x4* xr = (const f32x4*)(src + (size_t)row * DM) + lane;
        f32x4 v[8]; float s = 0.f;
#pragma unroll
        for (int j = 0; j < 8; ++j) { v[j] = xr[64 * j]; s += (v[j][0] + v[j][1]) + (v[j][2] + v[j][3]); }
        const float mean = wave_sum(s) * (1.f / DM); float s2 = 0.f;
#pragma unroll
        for (int j = 0; j < 8; ++j) { v[j] = v[j] - mean; s2 += (v[j][0] * v[j][0] + v[j][1] * v[j][1]) + (v[j][2] * v[j][2] + v[j][3] * v[j][3]); }
        const float rstd = 1.f / sqrtf(wave_sum(s2) * (1.f / DM) + LN_EPS);
#pragma unroll
        for (int j = 0; j < 8; ++j) { const f32x4 gg = *((const f32x4*)g + lane + 64 * j), bb = *((const f32x4*)bt + lane + 64 * j);
            const f32x4 y = v[j] * rstd * gg + bb;
            *((f32x4*)(dst + (size_t)row * DM) + lane + 64 * j) = y;
            if (xb) { u32x2 o; o.x = cvtpk(y[0], y[1]); o.y = cvtpk(y[2], y[3]); *((u32x2*)(xb + (size_t)row * DM) + lane + 64 * j) = o; } }
    }
}

DEV void phase_fixup(const float* RAW, bf16_t* ACT, const float* cw, const float* cb, int G) {
    const int NT = G * 512;
    for (int idx = blockIdx.x * 512 + opaque_tid(); idx < 64 * 2 * (DFF / 4); idx += NT) {
        const int f = (idx % (DFF / 4)) * 4, rr = (idx / (DFF / 4)) & 1, pm = idx / (2 * (DFF / 4));
        const int nl = 256 * (f >> 7) + (f & 127);
        float res[2][4];
#pragma unroll
        for (int gv = 0; gv < 2; ++gv) {
            const int nn = nl + gv * 128, ff = f + gv * DFF;
            const f32x4 c0 = *(const f32x4*)(RAW + (size_t)(pm * 4 + 0) * NUP + nn), c1 = *(const f32x4*)(RAW + (size_t)(pm * 4 + 1) * NUP + nn);
            f32x4 p2 = {0.f, 0.f, 0.f, 0.f}, p3 = {0.f, 0.f, 0.f, 0.f};
            if (pm & 7) { p2 = *(const f32x4*)(RAW + (size_t)((pm - 1) * 4 + 2) * NUP + nn); p3 = *(const f32x4*)(RAW + (size_t)((pm - 1) * 4 + 3) * NUP + nn); }
            const f32x4 w0 = *(const f32x4*)(cw + ff), w1 = *(const f32x4*)(cw + NUP + ff), w2 = *(const f32x4*)(cw + 2 * NUP + ff), bb = *(const f32x4*)(cb + ff);
            const f32x4 hm2 = rr ? p3 : p2, hm1 = rr ? c0 : p3, h0 = rr ? c1 : c0;
#pragma unroll
            for (int i = 0; i < 4; ++i) res[gv][i] = bb[i] + w0[i] * hm2[i] + w1[i] * hm1[i] + w2[i] * h0[i];
        }
        u32x2 o; o.x = cvtpk(siluf_(res[0][0]) * res[1][0], siluf_(res[0][1]) * res[1][1]); o.y = cvtpk(siluf_(res[0][2]) * res[1][2], siluf_(res[0][3]) * res[1][3]);
        *(u32x2*)(ACT + (size_t)(pm * 256 + rr) * DFF + f) = o;
    }
}

DEV void sincos_acc(float x, float& s, float& c) {
    const float k = rintf(x * 0.6366197723675814f);
    float r = fmaf(-k, 1.5707963705062866f, x); r = fmaf(-k, -4.371139006309477e-08f, r);
    const float r2 = r * r;
    const float sp = r + r * r2 * (-1.6666667e-1f + r2 * (8.3333333e-3f + r2 * (-1.9841270e-4f + r2 * 2.7557319e-6f)));
    const float cp = 1.0f + r2 * (-0.5f + r2 * (4.1666667e-2f + r2 * (-1.3888889e-3f + r2 * (2.4801587e-5f + r2 * -2.7557319e-7f))));
    const int q = ((int)k) & 3;
    s = (q == 0) ? sp : (q == 1) ? cp : (q == 2) ? -sp : -cp;
    c = (q == 0) ? cp : (q == 1) ? -sp : (q == 2) ? -cp : sp;
}
DEV void s5_wave(const Args& a, ldsp wl, int idx, int lane) {
    const int b = idx >> 6, g = idx & 63;
    const bf16_t* QKVU = (const bf16_t*)(a.ws + WS_QKV); bf16_t* Y = (bf16_t*)(a.ws + WS_Y);
    LAS float* BU = (LAS float*)wl;
    ldsp HB = wl + 18432;
    const float dt = expf(a.log_step[g]);
    const float lr = a.lam_re[g * 64 + lane], li = a.lam_im[g * 64 + lane];
    const float mag = expf(lr * dt); float sn, cs; sincos_acc(li * dt, sn, cs);
    const float ar = mag * cs, ai = mag * sn;
    const float den = lr * lr + li * li, xr = ar - 1.0f, xi = ai;
    const float gre = (xr * lr + xi * li) / den, gim = (xi * lr - xr * li) / den;
    const int hi = lane >> 5, c31 = lane & 31;
    bf16x8 Bf[4];
#pragma unroll
    for (int nb = 0; nb < 4; ++nb) { const int p2 = 32 * (nb & 1) + c31; const float gr = __shfl(gre, p2), gi = __shfl(gim, p2);
        const float* br = a.b_re + ((size_t)(g * 64 + p2) * 16 + 8 * hi); const float* bi = a.b_im + ((size_t)(g * 64 + p2) * 16 + 8 * hi);
        float v[8];
#pragma unroll
        for (int j = 0; j < 8; ++j) v[j] = (nb >> 1) ? (gr * bi[j] + gi * br[j]) : (gr * br[j] - gi * bi[j]);
        u32x4 w; w.x = cvtpk(v[0], v[1]); w.y = cvtpk(v[2], v[3]); w.z = cvtpk(v[4], v[5]); w.w = cvtpk(v[6], v[7]); Bf[nb] = __builtin_bit_cast(bf16x8, w); }
    const int c15 = lane & 15, kg = lane >> 4;
    bf16x8 Cf[4];
#pragma unroll
    for (int ks = 0; ks < 4; ++ks) { const f32x4 cr = *(const f32x4*)(a.c_re + ((size_t)(g * 16 + c15) * 64 + 16 * ks + 4 * kg)), ci = *(const f32x4*)(a.c_im + ((size_t)(g * 16 + c15) * 64 + 16 * ks + 4 * kg));
        u32x4 w; w.x = cvtpk(cr[0], -ci[0]); w.y = cvtpk(cr[1], -ci[1]); w.z = cvtpk(cr[2], -ci[2]); w.w = cvtpk(cr[3], -ci[3]); Cf[ks] = __builtin_bit_cast(bf16x8, w); }
    const f32x4 dsk = *(const f32x4*)(a.d_skip + g * 16 + 4 * kg);
    float hr = 0.f, him = 0.f;
    for (int blk = 0; blk < 64; ++blk) {
        const size_t tok0 = (size_t)b * SEQ + 32 * blk;
        const bf16x8 Uf = *(const bf16x8*)(QKVU + (tok0 + c31) * 4096 + 3072 + 16 * g + 8 * hi);
#pragma unroll
        for (int nb = 0; nb < 4; ++nb) {
            f32x16 z;
#pragma unroll
            for (int r = 0; r < 16; ++r) z[r] = 0.f;
            const f32x16 d = __builtin_amdgcn_mfma_f32_32x32x16_bf16(Uf, Bf[nb], z, 0, 0, 0);
            LAS float* dst = BU + (((nb >> 1) * 64 + 32 * (nb & 1) + c31) * 36 + 4 * hi);
#pragma unroll
            for (int q = 0; q < 4; ++q) *(LAS f32x4*)(dst + 8 * q) = (f32x4){d[4 * q], d[4 * q + 1], d[4 * q + 2], d[4 * q + 3]};
        }
        LDS_WAIT();
#pragma unroll
        for (int t4 = 0; t4 < 8; ++t4) {
            const f32x4 br = *(LAS f32x4*)(BU + (lane * 36 + 4 * t4)), bi = *(LAS f32x4*)(BU + ((64 + lane) * 36 + 4 * t4));
#pragma unroll
            for (int e = 0; e < 4; ++e) {
                const float nr = fmaf(-ai, him, fmaf(ar, hr, br[e])), ni = fmaf(ai, hr, fmaf(ar, him, bi[e]));
                hr = nr; him = ni;
                *(LAS unsigned*)(HB + (4 * t4 + e) * 272 + lane * 4) = cvtpk(hr, him);
            }
        }
        LDS_WAIT();
#pragma unroll
        for (int th = 0; th < 2; ++th) {
            f32x4 y = {0.f, 0.f, 0.f, 0.f};
#pragma unroll
            for (int ks = 0; ks < 4; ++ks) { const bf16x8 hf = *(LAS bf16x8*)(HB + (16 * th + c15) * 272 + 64 * ks + 16 * kg);
                y = __builtin_amdgcn_mfma_f32_16x16x32_bf16(Cf[ks], hf, y, 0, 0, 0); }
            const size_t tok = tok0 + 16 * th + c15;
            const u32x2 uu = *(const u32x2*)(QKVU + tok * 4096 + 3072 + 16 * g + 4 * kg);
            const float o0 = gelu_tanh(y[0] + dsk[0] * bflo(uu.x)), o1 = gelu_tanh(y[1] + dsk[1] * bfhi(uu.x));
            const float o2 = gelu_tanh(y[2] + dsk[2] * bflo(uu.y)), o3 = gelu_tanh(y[3] + dsk[3] * bfhi(uu.y));
            u32x2 o; o.x = cvtpk(o0, o1); o.y = cvtpk(o2, o3);
            *(u32x2*)(Y + tok * 1024 + 16 * g + 4 * kg) = o;
        }
        LDS_WAIT();
    }
}

DEV s16x4 vtr(ldsp p) { typedef short v4i16_t __attribute__((ext_vector_type(4))); return __builtin_bit_cast(s16x4, __builtin_amdgcn_ds_read_tr16_b64_v4i16((LAS v4i16_t*)p)); }
DEV int crow(int r, int hi) { return (r & 3) + 8 * (r >> 2) + 4 * hi; }

DEV void softmax_tile(f32x16& p0, f32x16& p1, float& m, float& l, float& alpha, bf16x8 (&pk)[4]) {
    float mx = fmaxf(p0[0], p1[0]);
#pragma unroll
    for (int r = 1; r < 16; ++r) mx = fmaxf(mx, fmaxf(p0[r], p1[r]));
    mx = fmaxf(mx, __shfl_xor(mx, 32));
    const float mn = fmaxf(m, mx);
    alpha = fast_exp2(m - mn); m = mn;
    float s = 0.f;
#pragma unroll
    for (int r = 0; r < 16; ++r) { p0[r] = fast_exp2(p0[r] - mn); p1[r] = fast_exp2(p1[r] - mn); s += p0[r] + p1[r]; }
    l = l * alpha + s;
#pragma unroll
    for (int sgrp = 0; sgrp < 4; ++sgrp) { const f32x16& p = (sgrp >> 1) ? p1 : p0; const int r0 = 8 * (sgrp & 1);
        u32x4 w; w.x = cvtpk(p[r0], p[r0 + 1]); w.y = cvtpk(p[r0 + 2], p[r0 + 3]); w.z = cvtpk(p[r0 + 4], p[r0 + 5]); w.w = cvtpk(p[r0 + 6], p[r0 + 7]);
        pk[sgrp] = __builtin_bit_cast(bf16x8, w); }
}

constexpr int FX_K0 = 0, FX_V0 = 32768, FX_CS = 65536, FX_WT = FX_CS + 8192;
DEV int fxs(int row) { return ((row & 3) << 2) | ((row >> 2) & 3); }
DEV void fox_unit(const Args& a, ldsp lds, int b, int h, int qb, int wave, int lane) {
    const bf16_t* QKVU = (const bf16_t*)(a.ws + WS_QKV); bf16_t* CAT = (bf16_t*)(a.ws + WS_CAT);
    const int hi = lane >> 5, c31 = lane & 31;
    const LAS float* cs = (const LAS float*)(lds + FX_CS);
    const int q0 = 256 * qb, qw0 = q0 + 32 * wave, qpos = qw0 + c31;
    const size_t rowb = (size_t)b * SEQ;
    bf16x8 qf[8];
#pragma unroll
    for (int d0 = 0; d0 < 8; ++d0) qf[d0] = *(const bf16x8*)(QKVU + (rowb + qpos) * 4096 + h * 128 + 16 * d0 + 8 * hi);
    const float cq = cs[qpos];
    f32x16 o[4];
#pragma unroll
    for (int db = 0; db < 4; ++db)
#pragma unroll
        for (int r = 0; r < 16; ++r) o[db][r] = 0.f;
    float m = -1e30f, l = 0.f;
    const int NT = 4 * (qb + 1);
    const int srow0 = 8 * wave + (lane >> 4), srow1 = srow0 + 4;
    const bf16_t* kg0 = QKVU + (rowb + srow0) * 4096 + 1024 + h * 128 + (((lane & 15) ^ fxs(srow0)) * 8);
    const bf16_t* kg1 = QKVU + (rowb + srow1) * 4096 + 1024 + h * 128 + (((lane & 15) ^ fxs(srow1)) * 8);
#define FOX_STAGE(kvrow0, buf) do { \
        __builtin_amdgcn_global_load_lds((const unsigned*)(kg0 + (size_t)(kvrow0) * 4096), (LAS unsigned*)(lds + FX_K0 + (buf) * 16384 + (2 * wave) * 1024), 16, 0, 0); \
        __builtin_amdgcn_global_load_lds((const unsigned*)(kg1 + (size_t)(kvrow0) * 4096), (LAS unsigned*)(lds + FX_K0 + (buf) * 16384 + (2 * wave + 1) * 1024), 16, 0, 0); \
        __builtin_amdgcn_global_load_lds((const unsigned*)(kg0 + (size_t)(kvrow0) * 4096 + 1024), (LAS unsigned*)(lds + FX_V0 + (buf) * 16384 + (2 * wave) * 1024), 16, 0, 0); \
        __builtin_amdgcn_global_load_lds((const unsigned*)(kg1 + (size_t)(kvrow0) * 4096 + 1024), (LAS unsigned*)(lds + FX_V0 + (buf) * 16384 + (2 * wave + 1) * 1024), 16, 0, 0); } while (0)
    FOX_STAGE(0, 0);
    asm volatile("s_waitcnt vmcnt(0)" ::: "memory");
    __syncthreads();
    const int i15 = lane & 15;
    const int fk = fxs(c31);
    const int vrow = 4 * hi + (i15 >> 2), vcl = 2 * ((lane >> 4) & 1) + ((i15 & 3) >> 1), vq = i15 >> 2;
    const int vlo_b = 256 * vrow + 16 * (vcl ^ hi) + 8 * (i15 & 1), vhi_b = 256 * (vrow + 8) + 16 * (vcl ^ (hi + 2)) + 8 * (i15 & 1);
    for (int j = 0; j < NT; ++j) {
        const int buf = j & 1, kv0 = 64 * j;
        if (j + 1 < NT) FOX_STAGE(kv0 + 64, buf ^ 1);
        if (kv0 <= qw0 + 31) {
            const ldsp KT = lds + FX_K0 + buf * 16384, VT = lds + FX_V0 + buf * 16384;
            f32x16 p0, p1;
#pragma unroll
            for (int gq = 0; gq < 4; ++gq) { const f32x4 c0 = *(const LAS f32x4*)(cs + kv0 + 8 * gq + 4 * hi), c1 = *(const LAS f32x4*)(cs + kv0 + 32 + 8 * gq + 4 * hi);
#pragma unroll
                for (int e = 0; e < 4; ++e) { p0[4 * gq + e] = cq - c0[e]; p1[4 * gq + e] = cq - c1[e]; } }
#pragma unroll
            for (int d0 = 0; d0 < 8; ++d0) {
                const int co = 16 * ((2 * d0 + hi) ^ fk);
                const bf16x8 ka = *(const LAS bf16x8*)(KT + c31 * 256 + co), kb = *(const LAS bf16x8*)(KT + (32 + c31) * 256 + co);
                p0 = __builtin_amdgcn_mfma_f32_32x32x16_bf16(ka, qf[d0], p0, 0, 0, 0); p1 = __builtin_amdgcn_mfma_f32_32x32x16_bf16(kb, qf[d0], p1, 0, 0, 0);
            }
            if (kv0 + 63 > qw0) {
#pragma unroll
                for (int r = 0; r < 16; ++r) { const int kv = kv0 + crow(r, hi); if (kv > qpos) p0[r] = -INFINITY; if (kv + 32 > qpos) p1[r] = -INFINITY; }
            }
            float alpha; bf16x8 pk[4];
            softmax_tile(p0, p1, m, l, alpha, pk);
#pragma unroll
            for (int db = 0; db < 4; ++db)
#pragma unroll
                for (int r = 0; r < 16; ++r) o[db][r] *= alpha;
#pragma unroll
            for (int db = 0; db < 4; ++db) {
                const int xo = 64 * (db ^ vq);
#pragma unroll
                for (int s = 0; s < 4; ++s) {
                    const s16x4 lo = vtr(VT + vlo_b + xo + s * 4096), hh = vtr(VT + vhi_b + xo + s * 4096);
                    const bf16x8 vf = {lo[0], lo[1], lo[2], lo[3], hh[0], hh[1], hh[2], hh[3]};
                    o[db] = __builtin_amdgcn_mfma_f32_32x32x16_bf16(vf, pk[s], o[db], 0, 0, 0);
                }
                __builtin_amdgcn_sched_barrier(0);
            }
        }
        asm volatile("s_waitcnt vmcnt(0)" ::: "memory");
        __syncthreads();
    }
#undef FOX_STAGE
    const float lt = l + __shfl_xor(l, 32); const float inv = 1.0f / lt;
    bf16_t* orow = CAT + (rowb + qpos) * DM + h * 128;
#pragma unroll
    for (int db = 0; db < 4; ++db)
#pragma unroll
        for (int gq = 0; gq < 4; ++gq) { u32x2 w; w.x = cvtpk(o[db][4 * gq] * inv, o[db][4 * gq + 1] * inv); w.y = cvtpk(o[db][4 * gq + 2] * inv, o[db][4 * gq + 3] * inv);
            *(u32x2*)(orow + 32 * db + 8 * gq + 4 * hi) = w; }
}
DEV void phase_fox_s5(const Args& a, ldsp lds, int wave, int lane, int tid) {
    if (wave < 2) s5_wave(a, lds + wave * 27136, blockIdx.x * 2 + wave, lane);
    __syncthreads();
    const int bh = blockIdx.x >> 2, s = blockIdx.x & 3, b = bh >> 3, h = bh & 7;
    {
        const float* LOGF = (const float*)(a.ws + WS_LOGF) + ((size_t)b * SEQ) * 8 + h;
        LAS float* cs = (LAS float*)(lds + FX_CS); LAS float* wt = (LAS float*)(lds + FX_WT);
        float v[4];
#pragma unroll
        for (int e = 0; e < 4; ++e) v[e] = LOGF[(size_t)(4 * tid + e) * 8];
        v[1] += v[0]; v[2] += v[1]; v[3] += v[2];
        float incl = v[3];
#pragma unroll
        for (int o = 1; o < 64; o <<= 1) { const float n = __shfl_up(incl, o); if (lane >= o) incl += n; }
        if (lane == 63) wt[wave] = incl;
        __syncthreads();
        float base = incl - v[3];
        for (int w = 0; w < wave; ++w) base += wt[w];
#pragma unroll
        for (int e = 0; e < 4; ++e) cs[4 * tid + e] = (base + v[e]) * LOG2E;
        __syncthreads();
    }
    fox_unit(a, lds, b, h, s, wave, lane);
    fox_unit(a, lds, b, h, 7 - s, wave, lane);
}

constexpr int SW_KP = 144, SW_VP = 192, SW_K0 = 0, SW_V0 = 256 * SW_KP;
DEV void swa_unit(const Args& a, ldsp lds, int u, int wave, int lane, int tid) {
    const bf16_t* QKV = (const bf16_t*)(a.ws + WS_QKV); bf16_t* CAT = (bf16_t*)(a.ws + WS_CAT);
    const int b = u >> 6, kvh = (u >> 4) & 3, n = u & 15, hi = lane >> 5, c31 = lane & 31;
    const size_t rowb = (size_t)b * SEQ;
    const int key0 = 128 * (n - 1);
#pragma unroll
    for (int i = 0; i < 4; ++i) { const int c = tid + 512 * i, row = c >> 3, ch = c & 7; const int key = key0 + row;
        if (key >= 0) { const bf16_t* src = QKV + (rowb + key) * ODD_IN + 2048 + kvh * 64 + ch * 8;
            *(LAS u32x4*)(lds + SW_K0 + row * SW_KP + ch * 16) = *(const u32x4*)src; *(LAS u32x4*)(lds + SW_V0 + row * SW_VP + ch * 16) = *(const u32x4*)(src + 256); } }
    __syncthreads();
    const int hq = 8 * kvh + wave;
    const float sink2 = a.od_sinks[hq] * LOG2E;
    const int i15 = lane & 15;
    const int vrd = (4 * hi + (i15 >> 2)) * SW_VP + (16 * ((lane >> 4) & 1) + 4 * (i15 & 3)) * 2;
    for (int sub = 0; sub < 4; ++sub) {
        const int ql = 128 + 32 * sub + c31;
        const size_t qrow = rowb + 128 * n + 32 * sub + c31;
        bf16x8 qf[4];
#pragma unroll
        for (int d0 = 0; d0 < 4; ++d0) qf[d0] = *(const bf16x8*)(QKV + qrow * ODD_IN + hq * 64 + 16 * d0 + 8 * hi);
        f32x16 o[2];
#pragma unroll
        for (int db = 0; db < 2; ++db)
#pragma unroll
            for (int r = 0; r < 16; ++r) o[db][r] = 0.f;
        float m = -1e30f, l = 0.f;
        const int T0 = sub >> 1;
        for (int T = T0; T < T0 + 3; ++T) {
            if (n == 0 && T < 2) continue;
            const ldsp KT = lds + SW_K0 + 64 * T * SW_KP, VT = lds + SW_V0 + 64 * T * SW_VP;
            f32x16 p0, p1;
#pragma unroll
            for (int r = 0; r < 16; ++r) { p0[r] = 0.f; p1[r] = 0.f; }
#pragma unroll
            for (int d0 = 0; d0 < 4; ++d0) {
                const bf16x8 ka = *(const LAS bf16x8*)(KT + c31 * SW_KP + (2 * d0 + hi) * 16), kb = *(const LAS bf16x8*)(KT + (32 + c31) * SW_KP + (2 * d0 + hi) * 16);
                p0 = __builtin_amdgcn_mfma_f32_32x32x16_bf16(ka, qf[d0], p0, 0, 0, 0); p1 = __builtin_amdgcn_mfma_f32_32x32x16_bf16(kb, qf[d0], p1, 0, 0, 0);
            }
#pragma unroll
            for (int r = 0; r < 16; ++r) { const int lr = 64 * T + crow(r, hi);
                if (lr > ql || lr <= ql - 128) p0[r] = -INFINITY;
                if (lr + 32 > ql || lr + 32 <= ql - 128) p1[r] = -INFINITY; }
            float alpha; bf16x8 pk[4];
            softmax_tile(p0, p1, m, l, alpha, pk);
#pragma unroll
            for (int db = 0; db < 2; ++db)
#pragma unroll
                for (int r = 0; r < 16; ++r) o[db][r] *= alpha;
#pragma unroll
            for (int db = 0; db < 2; ++db)
#pragma unroll
                for (int s = 0; s < 4; ++s) {
                    const s16x4 lo = vtr(VT + vrd + s * 16 * SW_VP + db * 64), hh = vtr(VT + vrd + (s * 16 + 8) * SW_VP + db * 64);
                    const bf16x8 vf = {lo[0], lo[1], lo[2], lo[3], hh[0], hh[1], hh[2], hh[3]};
                    o[db] = __builtin_amdgcn_mfma_f32_32x32x16_bf16(vf, pk[s], o[db], 0, 0, 0);
                }
        }
        const float M2 = fmaxf(m, sink2), f = fast_exp2(m - M2);
        const float lt = (l + __shfl_xor(l, 32)) * f + fast_exp2(sink2 - M2); const float inv = f / lt;
        bf16_t* orow = CAT + qrow * DM + hq * 64;
#pragma unroll
        for (int db = 0; db < 2; ++db)
#pragma unroll
            for (int gq = 0; gq < 4; ++gq) { u32x2 w; w.x = cvtpk(o[db][4 * gq] * inv, o[db][4 * gq + 1] * inv); w.y = cvtpk(o[db][4 * gq + 2] * inv, o[db][4 * gq + 3] * inv);
                *(u32x2*)(orow + 32 * db + 8 * gq + 4 * hi) = w; }
    }
    __syncthreads();
}

#define XB_TMO      128
#define XB_XCNT(j)  (256  + 64 * (j))
#define XB_XSUB(j)  (1280 + 64 * (j))
#define XB_XGEN(j)  (2304 + 64 * (j))
#define XB_TOP      3328
#define XB_TOPGEN   3392
#define XCD_BAR_WORDS 3456
#define XB_SPIN_CAP (1u << 22)
DEV unsigned xb_ld(unsigned* p)              { return __hip_atomic_load(p, __ATOMIC_RELAXED, __HIP_MEMORY_SCOPE_AGENT); }
DEV unsigned xb_add(unsigned* p, unsigned v) { return __hip_atomic_fetch_add(p, v, __ATOMIC_RELAXED, __HIP_MEMORY_SCOPE_AGENT); }
DEV unsigned xb_xcc_id() { return (unsigned)__builtin_amdgcn_s_getreg((3 << 11) | 20) & 0xFu; }
#define XB_SPIN(cond, bar) do { unsigned _sp = 0; while (cond) { __builtin_amdgcn_s_sleep(1); \
    if ((++_sp & 255u) == 0u) { if (xb_ld(&(bar)[XB_TMO])) break; if (_sp > XB_SPIN_CAP) { atomicAdd(&(bar)[XB_TMO], 1u); break; } } } } while (0)
struct XcdBarrier { unsigned* bar; unsigned x; volatile LAS unsigned* st; };
DEV XcdBarrier xcd_barrier_post(unsigned* bar, volatile LAS unsigned* st, int tid) {
    XcdBarrier b; b.bar = bar; b.x = xb_xcc_id(); b.st = st;
    if (tid == 0) (void)xb_add(&bar[XB_XCNT(b.x)], 1u);
    return b;
}
DEV void xcd_barrier_complete(unsigned* bar, unsigned x, unsigned& nloc, unsigned& nx) {
    const unsigned G = gridDim.x * gridDim.y * gridDim.z;
    unsigned sum, cnt, mine, sp = 0u;
    for (;;) {
        sum = 0u; cnt = 0u; mine = 0u;
#pragma unroll
        for (unsigned j = 0; j < 16; ++j) { const unsigned c = xb_ld(&bar[XB_XCNT(j)]); sum += c; cnt += (c > 0u) ? 1u : 0u; mine = (j == x) ? c : mine; }
        if (sum == G) break;
        __builtin_amdgcn_s_sleep(1);
        if ((++sp & 255u) == 0u) { if (xb_ld(&bar[XB_TMO])) break; if (sp > XB_SPIN_CAP) { atomicAdd(&bar[XB_TMO], 1u); break; } }
    }
    nloc = mine > 0u ? mine : 1u; nx = cnt > 0u ? cnt : 1u;
}
DEV void xcd_barrier(const XcdBarrier& b) {
    asm volatile("s_waitcnt vmcnt(0)" ::: "memory");
    __syncthreads();
    if (opaque_tid() == 0) {
        unsigned* bar = b.bar;
        __builtin_amdgcn_s_waitcnt(0);
        unsigned nloc = b.st[0], nx = b.st[1];
        if (nloc == 0u) { xcd_barrier_complete(bar, b.x, nloc, nx); b.st[0] = nloc; b.st[1] = nx; }
        const unsigned old = xb_add(&bar[XB_XSUB(b.x)], 1u);
        const unsigned gen = old / nloc;
        if (old + 1u == (gen + 1u) * nloc) {
            __builtin_amdgcn_fence(__ATOMIC_RELEASE, "agent");
            asm volatile("s_waitcnt vmcnt(0)" ::: "memory");
            const unsigned og = xb_add(&bar[XB_TOP], 1u);
            const unsigned tg = og / nx;
            if (og + 1u == (tg + 1u) * nx) xb_add(&bar[XB_TOPGEN], 1u);
            else XB_SPIN(xb_ld(&bar[XB_TOPGEN]) == tg, bar);
            __builtin_amdgcn_fence(__ATOMIC_ACQUIRE, "agent");
            xb_add(&bar[XB_XGEN(b.x)], 1u);
            asm volatile("s_waitcnt vmcnt(0)" ::: "memory");
        } else {
            XB_SPIN(xb_ld(&bar[XB_XGEN(b.x)]) == gen, bar);
            __builtin_amdgcn_fence(__ATOMIC_ACQUIRE, "agent");
            asm volatile("s_waitcnt vmcnt(0)" ::: "memory");
        }
    }
    __syncthreads();
}

__global__ void __launch_bounds__(512, 2) fwd_megakernel(Args a) {
    extern __shared__ __attribute__((aligned(16))) unsigned char lds_raw[];
    cg::grid_group grid = cg::this_grid();
    const ldsp lds = (ldsp)lds_raw;
    const int G = gridDim.x;
    unsigned char* ws = a.ws;
    { const int t0 = opaque_tid(); if (t0 < 2) ((volatile LAS unsigned*)(lds + MISC_OFF))[t0] = 0u; }
    __syncthreads();
    XcdBarrier xbar = xcd_barrier_post((unsigned*)(ws + WS_BAR), (volatile LAS unsigned*)(lds + MISC_OFF), opaque_tid());
    bf16_t* XB = (bf16_t*)(ws + WS_XB); bf16_t* QKV = (bf16_t*)(ws + WS_QKV); bf16_t* YB = (bf16_t*)(ws + WS_Y); bf16_t* CAT = (bf16_t*)(ws + WS_CAT); bf16_t* ACT = (bf16_t*)(ws + WS_ACT);
    float* RAW = (float*)(ws + WS_RAW);
    pg8::StaticOrder S;

    { const int tid = opaque_tid(); phase_prologue(a, lds, __builtin_amdgcn_readfirstlane(tid >> 6), tid & 63, tid, G); }
    grid.sync();
    { pg8::Gemm g{XB, (const bf16_t*)(ws + WS_WIN0), MTOK, 4096, 2048}; S.init(MTOK, 4096, G, blockIdx.x); pg8::EpiBf16 E{QKV, 4096, 4, C2_FOX}; pg8::gemm_phase(lds, g, S, E); }
    xcd_barrier(xbar);
    { const int tid = opaque_tid(); phase_fox_s5(a, lds, __builtin_amdgcn_readfirstlane(tid >> 6), tid & 63, tid); }
    xcd_barrier(xbar);
    { pg8::Gemm g{YB, (const bf16_t*)(ws + WS_WGLU), MTOK, 2048, 1024}; S.init(MTOK, 2048, G, blockIdx.x); pg8::EpiGlu E{CAT + 1024, DM}; pg8::gemm_phase(lds, g, S, E); }
    xcd_barrier(xbar);
    { pg8::Gemm g{CAT, (const bf16_t*)(ws + WS_WOUT0), MTOK, 2048, 2048}; S.init(MTOK, 2048, G, blockIdx.x); pg8::EpiRes E{a.x, a.out}; pg8::gemm_phase(lds, g, S, E); }
    xcd_barrier(xbar);
    { const int tid = opaque_tid(); phase_ln(a.out, a.out, XB, a.ln_mix_g, a.ln_mix_b, __builtin_amdgcn_readfirstlane(tid >> 6), tid & 63, G); }
    xcd_barrier(xbar);
    { pg8::Gemm g{XB, (const bf16_t*)(ws + WS_WUP0), MTOK, NUP, 2048}; S.init(MTOK, NUP, G, blockIdx.x); pg8::EpiUp E{ACT, RAW, a.conv_w, a.conv_b}; pg8::gemm_phase(lds, g, S, E); }
    xcd_barrier(xbar);
    phase_fixup(RAW, ACT, a.conv_w, a.conv_b, G);
    xcd_barrier(xbar);
    { pg8::Gemm g{ACT, (const bf16_t*)(ws + WS_WDN0), MTOK, 2048, DFF}; S.init(MTOK, 2048, G, blockIdx.x); pg8::EpiRes E{a.out, a.out}; pg8::gemm_phase(lds, g, S, E); }
    xcd_barrier(xbar);
    { const int tid = opaque_tid(); phase_ln(a.out, a.out, XB, a.ln_ffn_g, a.ln_ffn_b, __builtin_amdgcn_readfirstlane(tid >> 6), tid & 63, G); }
    xcd_barrier(xbar);
    { pg8::Gemm g{XB, (const bf16_t*)(ws + WS_WIN1), MTOK, ODD_IN, 2048}; S.init(MTOK, ODD_IN, G, blockIdx.x); pg8::EpiRope E{QKV, a.pos}; pg8::gemm_phase(lds, g, S, E); }
    xcd_barrier(xbar);
    { const int tid = opaque_tid(); for (int u = blockIdx.x; u < 512; u += G) swa_unit(a, lds, u, __builtin_amdgcn_readfirstlane(tid >> 6), tid & 63, tid); }
    xcd_barrier(xbar);
    { pg8::Gemm g{CAT, (const bf16_t*)(ws + WS_WOUT1), MTOK, 2048, 2048}; S.init(MTOK, 2048, G, blockIdx.x); pg8::EpiRes E{a.out, a.out}; pg8::gemm_phase(lds, g, S, E); }
    xcd_barrier(xbar);
    { const int tid = opaque_tid(); phase_ln(a.out, a.out, XB, a.ln_mix_g + DM, a.ln_mix_b + DM, __builtin_amdgcn_readfirstlane(tid >> 6), tid & 63, G); }
    xcd_barrier(xbar);
    { pg8::Gemm g{XB, (const bf16_t*)(ws + WS_WUP1), MTOK, NUP, 2048}; S.init(MTOK, NUP, G, blockIdx.x); pg8::EpiUp E{ACT, RAW, a.conv_w + 3 * NUP, a.conv_b + NUP}; pg8::gemm_phase(lds, g, S, E); }
    xcd_barrier(xbar);
    phase_fixup(RAW, ACT, a.conv_w + 3 * NUP, a.conv_b + NUP, G);
    xcd_barrier(xbar);
    { pg8::Gemm g{ACT, (const bf16_t*)(ws + WS_WDN1), MTOK, 2048, DFF}; S.init(MTOK, 2048, G, blockIdx.x); pg8::EpiRes E{a.out, a.out}; pg8::gemm_phase(lds, g, S, E); }
    xcd_barrier(xbar);
    { const int tid = opaque_tid(); phase_ln(a.out, a.out, nullptr, a.ln_ffn_g + DM, a.ln_ffn_b + DM, __builtin_amdgcn_readfirstlane(tid >> 6), tid & 63, G); }
}

extern "C" void kernel_launch(void* const* d_in, const int* in_sizes, int n_in, void* d_out, int out_size, void* d_ws, size_t ws_size, hipStream_t stream) {
    static int grid = 0;
    if (grid == 0) {
        if (n_in != 25 || out_size != MTOK * DM || ws_size < WS_END) { fprintf(stderr, "kernel_launch: unexpected shapes (n_in %d out %d ws %zu)\n", n_in, out_size, ws_size); grid = -1; return; }
        int dev = 0, cus = 0, per_cu = 0;
        (void)hipGetDevice(&dev); (void)hipDeviceGetAttribute(&cus, hipDeviceAttributeMultiprocessorCount, dev);
        if (hipFuncSetAttribute((const void*)fwd_megakernel, hipFuncAttributeMaxDynamicSharedMemorySize, LDS_BYTES) != hipSuccess) { fprintf(stderr, "kernel_launch: hipFuncSetAttribute failed\n"); grid = -1; return; }
        if (hipOccupancyMaxActiveBlocksPerMultiprocessor(&per_cu, (const void*)fwd_megakernel, 512, LDS_BYTES) != hipSuccess || per_cu < 1) { fprintf(stderr, "kernel_launch: occupancy query says %d blocks per CU\n", per_cu); per_cu = 1; }
        (void)hipGetLastError();
        grid = cus;
        if (grid > 256) grid = 256;
    }
    if (grid < 0) return;
    Args a{};
    a.x = (const float*)d_in[0]; a.pos = (const int*)d_in[1];
    a.ev_w_in = (const float*)d_in[2]; a.ev_b_f = (const float*)d_in[3]; a.lam_re = (const float*)d_in[4]; a.lam_im = (const float*)d_in[5]; a.log_step = (const float*)d_in[6];
    a.b_re = (const float*)d_in[7]; a.b_im = (const float*)d_in[8]; a.c_re = (const float*)d_in[9]; a.c_im = (const float*)d_in[10]; a.d_skip = (const float*)d_in[11];
    a.w_glu = (const float*)d_in[12]; a.ev_w_out = (const float*)d_in[13]; a.od_w_in = (const float*)d_in[14]; a.od_sinks = (const float*)d_in[15]; a.od_w_out = (const float*)d_in[16];
    a.ln_mix_g = (const float*)d_in[17]; a.ln_mix_b = (const float*)d_in[18]; a.w_up = (const float*)d_in[19]; a.conv_w = (const float*)d_in[20]; a.conv_b = (const float*)d_in[21];
    a.w_down = (const float*)d_in[22]; a.ln_ffn_g = (const float*)d_in[23]; a.ln_ffn_b = (const float*)d_in[24];
    a.out = (float*)d_out; a.ws = (unsigned char*)d_ws;
    (void)hipMemsetAsync((char*)d_ws + WS_BAR, 0, XCD_BAR_WORDS * 4, stream);
    void* args[] = {&a};
    hipError_t e = hipLaunchCooperativeKernel((const void*)fwd_megakernel, dim3(grid), dim3(512), args, LDS_BYTES, stream);
    if (e != hipSuccess) fprintf(stderr, "kernel_launch: cooperative launch failed: %s (grid %d)\n", hipGetErrorString(e), grid);
}
```
